# Optimizing an MI355X kernel written in HIP

```python
import math
import jax
import jax.numpy as jnp
from jax import lax
import numpy as np


D_MODEL = 1024
BATCH = 8
SEQ = 4096
DEPTH = 4

GRID_W = 64
CTX_LEN = 256
HEAD_DIM = 64
DIFF_HEADS = 4
DIFF_V_DIM = 2 * HEAD_DIM
DIFF_WIDTH = DIFF_HEADS * DIFF_V_DIM
POOL_WINDOWS = (2, 4, 8, 16)
POOL_GROUP = 64
POOL_WIDTH = POOL_GROUP * len(POOL_WINDOWS)
RET_HEADS = 4
RET_WIDTH = RET_HEADS * HEAD_DIM
RET_CHUNK = 128
MIX_WIDTH = DIFF_WIDTH + POOL_WIDTH + RET_WIDTH
OFF_DQ = 0
OFF_DK = OFF_DQ + DIFF_HEADS * 2 * HEAD_DIM
OFF_DV = OFF_DK + DIFF_HEADS * 2 * HEAD_DIM
OFF_PU = OFF_DV + DIFF_WIDTH
OFF_RQ = OFF_PU + POOL_WIDTH
OFF_RK = OFF_RQ + RET_WIDTH
OFF_RV = OFF_RK + RET_WIDTH
OFF_RG = OFF_RV + RET_WIDTH
IN_WIDTH = OFF_RG + RET_WIDTH
Q_BLOCK = 128
ROPE_BASE = 10000.0
ROPE_FREQS = HEAD_DIM // 4
N_EXPERTS = 16
N_GROUPS = 4
EXPERTS_PER_GROUP = N_EXPERTS // N_GROUPS
TOP_K = 2
D_EXPERT = 768
MOE_BLOCK = 128
N_MOD = 6
EPS = 1e-6

kernel_name = 'hybrid_diff_pool_retention_moe_dit'


def rmsnorm(x, w):
    xf = x.astype(jnp.float32)
    y = xf * lax.rsqrt(jnp.mean(xf * xf, axis=-1, keepdims=True) + EPS)
    return y.astype(x.dtype) * w


def modulate(h, shift, scale):
    return h * (1 + scale) + shift


def axial_rope_tables(L):
    rows = L // GRID_W
    row = jnp.repeat(jnp.arange(rows), GRID_W).astype(jnp.float32)
    col = jnp.tile(jnp.arange(GRID_W), rows).astype(jnp.float32)
    inv = ROPE_BASE ** (-jnp.arange(ROPE_FREQS, dtype=jnp.float32) / ROPE_FREQS)
    ang_r = row[:, None] * inv
    ang_c = col[:, None] * inv
    ang = jnp.concatenate([ang_r, ang_r, ang_c, ang_c], axis=-1)
    return jnp.cos(ang), jnp.sin(ang)


def rotate_half_axial(x):
    shp = x.shape
    xr = x.reshape(shp[:-1] + (2, 2, ROPE_FREQS))
    x1 = xr[..., 0, :]
    x2 = xr[..., 1, :]
    return jnp.stack([-x2, x1], axis=-2).reshape(shp)


def apply_rope(x, cos, sin):
    extra = x.ndim - 3
    shp = (cos.shape[0],) + (1,) * extra + (HEAD_DIM,)
    return (x * cos.reshape(shp) + rotate_half_axial(x) * sin.reshape(shp)).astype(x.dtype)


def split_proj(p):
    B, L, _ = p.shape
    dq = p[..., OFF_DQ:OFF_DK].reshape(B, L, DIFF_HEADS, 2, HEAD_DIM)
    dk = p[..., OFF_DK:OFF_DV].reshape(B, L, DIFF_HEADS, 2, HEAD_DIM)
    dv = p[..., OFF_DV:OFF_PU].reshape(B, L, DIFF_HEADS, DIFF_V_DIM)
    pu = p[..., OFF_PU:OFF_RQ]
    rq = p[..., OFF_RQ:OFF_RK].reshape(B, L, RET_HEADS, HEAD_DIM)
    rk = p[..., OFF_RK:OFF_RV].reshape(B, L, RET_HEADS, HEAD_DIM)
    rv = p[..., OFF_RV:OFF_RG].reshape(B, L, RET_HEADS, HEAD_DIM)
    rg = p[..., OFF_RG:IN_WIDTH]
    return dq, dk, dv, pu, rq, rk, rv, rg


def diff_softmax_attend(q, k, v, lam):
    s = jnp.einsum('bqhmd,bkhmd->bhmqk', q, k).astype(jnp.float32) * (HEAD_DIM ** -0.5)
    p = jax.nn.softmax(s, axis=-1)
    p = (p[:, :, 0] - lam * p[:, :, 1]).astype(v.dtype)
    return jnp.einsum('bhqk,bkhe->bqhe', p, v)


def diff_attention_latent(q, k, v, lam):
    B, L = q.shape[:2]
    nq = L // Q_BLOCK
    qb = jnp.moveaxis(q.reshape((B, nq, Q_BLOCK) + q.shape[2:]), 1, 0)
    out = lax.map(lambda blk: diff_softmax_attend(blk, k, v, lam), qb)
    return jnp.moveaxis(out, 0, 1).reshape((B, L) + out.shape[3:])


def diff_head_norm(o, w, lam_init):
    o = rmsnorm(o, w) * (1.0 - lam_init)
    return o.reshape(o.shape[0], o.shape[1], DIFF_WIDTH)


def multiscale_pool(u, w, scale):
    B, L, _ = u.shape
    csum = jnp.concatenate([jnp.zeros((B, 1, POOL_WIDTH), jnp.float32),
                            jnp.cumsum(u.astype(jnp.float32), axis=1)], axis=1)
    t = jnp.arange(L)
    outs = []
    for g, win in enumerate(POOL_WINDOWS):
        lo = jnp.clip(t - win // 2, 0, L)
        hi = jnp.clip(t + win - win // 2, 0, L)
        cs = csum[..., g * POOL_GROUP:(g + 1) * POOL_GROUP]
        mean = (cs[:, hi] - cs[:, lo]) / (hi - lo).astype(jnp.float32)[:, None]
        diff = mean.astype(u.dtype) - u[..., g * POOL_GROUP:(g + 1) * POOL_GROUP]
        outs.append(diff @ w[g])
    return jnp.concatenate(outs, axis=-1) * scale


def retention_chunked(q, k, v, log_g, state0, strict):
    B, H, L, dk = q.shape
    dv = v.shape[-1]
    n = L // RET_CHUNK
    qc = q.reshape(B, H, n, RET_CHUNK, dk)
    kc = k.reshape(B, H, n, RET_CHUNK, dk)
    vc = v.reshape(B, H, n, RET_CHUNK, dv)
    i = jnp.arange(RET_CHUNK, dtype=jnp.float32)
    dist = i[:, None] - i[None, :]
    keep = (dist > 0) if strict else (dist >= 0)
    decay = jnp.where(keep, jnp.exp(log_g[:, None, None] * jnp.maximum(dist, 0.0)), 0.0)
    scores = jnp.einsum('bhncd,bhnsd->bhncs', qc, kc) * decay[None, :, None]
    y = jnp.einsum('bhncs,bhnse->bhnce', scores, vc)
    zeta = jnp.exp(log_g[:, None] * (RET_CHUNK - 1 - i))
    xi = jnp.exp(log_g[:, None] * (i + 1))
    kv = jnp.einsum('bhnsd,bhnse->nbhde', kc * zeta[None, :, None, :, None], vc)
    g_chunk = jnp.exp(log_g * RET_CHUNK)[None, :, None, None]

    def step(R, kv_n):
        return g_chunk * R + kv_n, R

    _, r_prev = lax.scan(step, state0, kv)
    cross = jnp.einsum('bhncd,nbhde->bhnce', qc * xi[None, :, None, :, None], r_prev)
    return (y + cross).reshape(B, H, L, dv)


def retention_final_state(k, v, log_g, reverse):
    L = k.shape[2]
    j = jnp.arange(L, dtype=jnp.float32)
    dist = j if reverse else (L - 1 - j)
    w = jnp.exp(log_g[:, None] * dist)
    return jnp.einsum('bhld,bhle->bhde', k * w[None, :, :, None], v)


def bidir_retention(q, k, v, lg_f, lg_b, state_f, state_b):
    y_f = retention_chunked(q, k, v, lg_f, state_f, False)
    rev = lambda a: a[:, :, ::-1]
    y_b = rev(retention_chunked(rev(q), rev(k), rev(v), lg_b, state_b, True))
    return y_f + y_b


def retention_output(y, gate, w):
    y = jnp.moveaxis(y, 1, 2)
    y = y * lax.rsqrt(jnp.mean(y * y, axis=-1, keepdims=True) + EPS)
    y = y.reshape(y.shape[0], y.shape[1], RET_WIDTH).astype(gate.dtype) * w
    return jax.nn.silu(gate) * y


def hybrid_mixer(h, hc, cos, sin, w_in, w_out, diff_lambda, diff_norm_w, lam_init,
                 pool_w, pool_scale, ret_a_f, ret_a_b, ret_norm_w, need_ctx):
    dq, dk, dv, pu, rq, rk, rv, rg = split_proj(h @ w_in)
    cq, ck, cv, cu, crq, crk, crv, crg = split_proj(hc @ w_in)
    lam = (jnp.exp(jnp.sum(diff_lambda[0] * diff_lambda[1])) - jnp.exp(jnp.sum(diff_lambda[2] * diff_lambda[3]))
           + lam_init).astype(jnp.float32)
    dq = apply_rope(dq, cos, sin)
    dk = apply_rope(dk, cos, sin)
    k_all = jnp.concatenate([ck, dk], axis=1)
    v_all = jnp.concatenate([cv, dv], axis=1)
    a = diff_head_norm(diff_attention_latent(dq, k_all, v_all, lam), diff_norm_w, lam_init)
    b = multiscale_pool(pu, pool_w, pool_scale)
    lg_f = -jnp.exp(ret_a_f.astype(jnp.float32))
    lg_b = -jnp.exp(ret_a_b.astype(jnp.float32))
    k_scale = HEAD_DIM ** -0.5
    to_heads = lambda t: jnp.moveaxis(t, 2, 1).astype(jnp.float32)
    rq_h = to_heads(apply_rope(rq, cos, sin))
    rk_h = to_heads(apply_rope(rk, cos, sin)) * k_scale
    rv_h = to_heads(rv)
    crq_h = to_heads(crq)
    crk_h = to_heads(crk) * k_scale
    crv_h = to_heads(crv)
    s_f = retention_final_state(crk_h, crv_h, lg_f, False)
    s_b = retention_final_state(crk_h, crv_h, lg_b, True)
    r = retention_output(bidir_retention(rq_h, rk_h, rv_h, lg_f, lg_b, s_f, s_b), rg, ret_norm_w)
    out = jnp.concatenate([a, b, r], axis=-1) @ w_out
    if not need_ctx:
        return out, None
    zero = jnp.zeros_like(s_f)
    a_c = diff_head_norm(diff_softmax_attend(cq, ck, cv, lam), diff_norm_w, lam_init)
    b_c = multiscale_pool(cu, pool_w, pool_scale)
    r_c = retention_output(bidir_retention(crq_h, crk_h, crv_h, lg_f, lg_b, zero, zero), crg, ret_norm_w)
    out_c = jnp.concatenate([a_c, b_c, r_c], axis=-1) @ w_out
    return out, out_c


def grouped_moe(h, router_w, router_b, w_gate, w_up, w_down):
    T, D = h.shape
    s = jax.nn.sigmoid(h.astype(jnp.float32) @ router_w.astype(jnp.float32))
    s_sel = (s + router_b.astype(jnp.float32)).reshape(T, N_GROUPS, EXPERTS_PER_GROUP)
    grp_score = lax.top_k(s_sel, TOP_K)[0].sum(-1)
    g_idx = jnp.argmax(grp_score, axis=-1)
    in_grp = jnp.take_along_axis(s_sel, g_idx[:, None, None], axis=1)[:, 0]
    loc = lax.top_k(in_grp, TOP_K)[1]
    e_idx = g_idx[:, None] * EXPERTS_PER_GROUP + loc
    s_top = jnp.take_along_axis(s, e_idx, axis=1)
    gates = s_top / jnp.sum(s_top, axis=-1, keepdims=True)
    A = T * TOP_K
    flat_e = e_idx.reshape(A).astype(jnp.int32)
    flat_tok = jnp.repeat(jnp.arange(T, dtype=jnp.int32), TOP_K)
    order = jnp.argsort(flat_e)
    se = flat_e[order]
    stok = flat_tok[order]
    sg = gates.reshape(A)[order]
    counts = jax.ops.segment_sum(jnp.ones((A,), jnp.int32), flat_e, num_segments=N_EXPERTS)
    padded = (counts + MOE_BLOCK - 1) // MOE_BLOCK * MOE_BLOCK
    start = jnp.cumsum(counts) - counts
    pend = jnp.cumsum(padded)
    pstart = pend - padded
    dest = pstart[se] + jnp.arange(A, dtype=jnp.int32) - start[se]
    n_blk = -(-A // MOE_BLOCK) + N_EXPERTS
    xs = jnp.zeros((n_blk * MOE_BLOCK, D), h.dtype).at[dest].set(h[stok])
    blk_e = jnp.minimum(jnp.searchsorted(pend, jnp.arange(n_blk, dtype=jnp.int32) * MOE_BLOCK, side='right'),
                        N_EXPERTS - 1)

    def expert_block(args):
        xb, e = args
        return (jax.nn.silu(xb @ w_gate[e]) * (xb @ w_up[e])) @ w_down[e]

    ys = lax.map(expert_block, (xs.reshape(n_blk, MOE_BLOCK, D), blk_e)).reshape(n_blk * MOE_BLOCK, D)
    return jax.ops.segment_sum(ys[dest] * sg[:, None].astype(ys.dtype), stok, num_segments=T)


def setup_inputs(seed: int = 0) -> dict:
    key = jax.random.key(seed)
    ks = jax.random.split(key, 24)
    D = D_MODEL
    nrm = lambda k, shape, scale: jax.random.normal(k, shape, jnp.float32) * scale
    base_decay = -(5.0 + jnp.arange(RET_HEADS, dtype=jnp.float32)) * math.log(2.0)
    return {
        'x': nrm(ks[0], (BATCH, SEQ, D), 1.0),
        'c': nrm(ks[1], (BATCH, D), 1.0),
        'ctx': nrm(ks[2], (BATCH, CTX_LEN, D), 1.0),
        'c_ctx': nrm(ks[3], (D,), 1.0),
        'w_in': nrm(ks[4], (DEPTH, D, IN_WIDTH), D ** -0.5),
        'w_out': nrm(ks[5], (DEPTH, MIX_WIDTH, D), MIX_WIDTH ** -0.5),
        'ada_w': nrm(ks[6], (DEPTH, D, N_MOD * D), 0.5 * D ** -0.5),
        'ada_b': nrm(ks[7], (DEPTH, N_MOD * D), 0.02),
        'norm1_w': 1.0 + nrm(ks[8], (DEPTH, D), 0.05),
        'norm2_w': 1.0 + nrm(ks[9], (DEPTH, D), 0.05),
        'diff_lambda': nrm(ks[10], (DEPTH, 4, HEAD_DIM), 0.1),
        'diff_norm_w': 1.0 + nrm(ks[11], (DEPTH, DIFF_V_DIM), 0.05),
        'pool_w': nrm(ks[12], (DEPTH, len(POOL_WINDOWS), POOL_GROUP, POOL_GROUP), POOL_GROUP ** -0.5),
        'pool_scale': 1.0 + nrm(ks[13], (DEPTH, POOL_WIDTH), 0.1),
        'ret_a_f': base_decay + nrm(ks[14], (DEPTH, RET_HEADS), 0.1),
        'ret_a_b': base_decay + nrm(ks[15], (DEPTH, RET_HEADS), 0.1),
        'ret_norm_w': 1.0 + nrm(ks[16], (DEPTH, RET_WIDTH), 0.05),
        'router_w': nrm(ks[17], (D, N_EXPERTS), D ** -0.5),
        'router_b': nrm(ks[18], (N_EXPERTS,), 0.01),
        'moe_w_gate': nrm(ks[19], (DEPTH, N_EXPERTS, D, D_EXPERT), D ** -0.5),
        'moe_w_up': nrm(ks[20], (DEPTH, N_EXPERTS, D, D_EXPERT), D ** -0.5),
        'moe_w_down': nrm(ks[21], (DEPTH, N_EXPERTS, D_EXPERT, D), D_EXPERT ** -0.5),
        'final_norm_w': 1.0 + nrm(ks[22], (D,), 0.05),
    }


def reference(x, c, ctx, c_ctx, w_in, w_out, ada_w, ada_b, norm1_w, norm2_w, diff_lambda, diff_norm_w,
              pool_w, pool_scale, ret_a_f, ret_a_b, ret_norm_w, router_w, router_b,
              moe_w_gate, moe_w_up, moe_w_down, final_norm_w):
    B, L, D = x.shape
    Lc = ctx.shape[1]
    cos, sin = axial_rope_tables(L)
    xc = ctx
    for l in range(DEPTH):
        last = l == DEPTH - 1
        lam_init = 0.8 - 0.6 * math.exp(-0.3 * l)
        mod = jax.nn.silu(c) @ ada_w[l] + ada_b[l]
        mod_c = jax.nn.silu(c_ctx) @ ada_w[l] + ada_b[l]
        sh1, sc1, g1, sh2, sc2, g2 = jnp.split(mod[:, None, :], N_MOD, axis=-1)
        csh1, csc1, cg1, csh2, csc2, cg2 = jnp.split(mod_c, N_MOD, axis=-1)
        h = modulate(rmsnorm(x, norm1_w[l]), sh1, sc1)
        hc = modulate(rmsnorm(xc, norm1_w[l]), csh1, csc1)
        y, yc = hybrid_mixer(h, hc, cos, sin, w_in[l], w_out[l], diff_lambda[l], diff_norm_w[l], lam_init,
                             pool_w[l], pool_scale[l], ret_a_f[l], ret_a_b[l], ret_norm_w[l], not last)
        x = x + g1 * y
        h = modulate(rmsnorm(x, norm2_w[l]), sh2, sc2)
        if last:
            f = grouped_moe(h.reshape(B * L, D), router_w, router_b, moe_w_gate[l], moe_w_up[l], moe_w_down[l])
            x = x + g2 * f.reshape(B, L, D)
        else:
            xc = xc + cg1 * yc
            hc = modulate(rmsnorm(xc, norm2_w[l]), csh2, csc2)
            tokens = jnp.concatenate([hc.reshape(B * Lc, D), h.reshape(B * L, D)], axis=0)
            f = grouped_moe(tokens, router_w, router_b, moe_w_gate[l], moe_w_up[l], moe_w_down[l])
            xc = xc + cg2 * f[:B * Lc].reshape(B, Lc, D)
            x = x + g2 * f[B * Lc:].reshape(B, L, D)
    return rmsnorm(x, final_norm_w)
```

```cpp
#include <hip/hip_runtime.h>
#include <cstdio>
#include <cstdint>

#define LAS __attribute__((address_space(3)))
#define GAS __attribute__((address_space(1)))
typedef unsigned short bf16_t;
typedef short bf16x8 __attribute__((ext_vector_type(8)));
typedef short s16x4 __attribute__((ext_vector_type(4)));
typedef float f32x2 __attribute__((ext_vector_type(2)));
typedef float f32x4 __attribute__((ext_vector_type(4)));
typedef float f32x16 __attribute__((ext_vector_type(16)));
typedef unsigned u32x2 __attribute__((ext_vector_type(2)));
typedef unsigned u32x4 __attribute__((ext_vector_type(4)));

constexpr int D = 1024, NB = 8, L = 4096, LC = 256, LT = L + LC, M = NB * LT;
constexpr int DEPTH = 4, INW = 2816;
constexpr int OFF_DQ = 0, OFF_DK = 512, OFF_DV = 1024, OFF_PU = 1536, OFF_RQ = 1792, OFF_RK = 2048, OFF_RV = 2304, OFF_RG = 2560;
constexpr int NE = 16, DE = 768, NGU = 2 * DE;
constexpr int NCH = LT / 128;
constexpr int CAP = M;
constexpr int ACT_ROWS = 73728;
constexpr float EPS = 1e-6f;
constexpr float LOG2E = 1.4426950408889634f;

constexpr size_t MiB = 1u << 20;
constexpr size_t WS_CTL = 0, CTL_ZERO_BYTES = 1 * MiB;
constexpr size_t WS_MOD = 1 * MiB;
constexpr size_t WS_ROPE = 2 * MiB;
constexpr size_t WS_POOLW = 2 * MiB + 16384;
constexpr size_t WS_GATE = 3 * MiB;
constexpr size_t WS_TOK = 4 * MiB;
constexpr size_t WS_XC = 8 * MiB;
constexpr size_t WS_KV = 16 * MiB;
constexpr size_t WS_ST = 50 * MiB;
constexpr size_t WS_WIN = 68 * MiB;
constexpr size_t WS_WOUT = 90 * MiB;
constexpr size_t WS_WGU = 98 * MiB;
constexpr size_t WS_WDN = 194 * MiB;
constexpr size_t WS_H8 = 242 * MiB;
constexpr size_t WS_QK8 = 276 * MiB;
constexpr size_t WS_VT8 = 312 * MiB;
constexpr size_t WS_H = 330 * MiB;
constexpr size_t WS_XB = 386 * MiB;
constexpr size_t WS_P = 454 * MiB;
constexpr size_t WS_MIX = 641 * MiB;
constexpr size_t WS_ACT = WS_P;
constexpr size_t WS_Y2 = 562 * MiB;
constexpr size_t WS_K8T = 709 * MiB;
constexpr size_t WS_END = 727 * MiB;
constexpr size_t K8T_OFF = WS_K8T - WS_QK8;
static_assert(WS_ACT + (size_t)ACT_ROWS * DE * 2 <= WS_Y2 && WS_Y2 + (size_t)2 * M * D * 2 <= WS_END, "ws map");
static_assert(WS_P + (size_t)M * INW * 2 <= WS_MIX && WS_MIX + (size_t)M * D * 2 <= WS_END, "ws map");
constexpr int CW_TMO = 0;
constexpr int CW_BAR = 4096;
constexpr int CW_CTX = 8192;
constexpr int CW_CNT = 16384;

constexpr int RING_BYTES = 131072;
constexpr int LDSCTL_OFF = 0, LDSCTL_BYTES = 8192, RING_OFF = LDSCTL_BYTES;
constexpr int LDS_BYTES = 147456;
constexpr int LC_BARW = 0;
constexpr int LC_TP = 64;
constexpr int LC_CNT = 160;
constexpr int LC_LCNT = 256;
constexpr int LC_BASE = 320;
constexpr int LC_PTR = 512;
constexpr int LC_PART = 1024;
constexpr int LC_RG = 1536;
constexpr int LC_RI = 3072;

__device__ __forceinline__ int opaque_int(int v) { asm volatile("" : "+s"(v)); return v; }
__device__ __forceinline__ int opaque_tid(int wave0) { int w = wave0; asm volatile("" : "+s"(w)); int t; asm volatile("v_mbcnt_lo_u32_b32 %0, -1, 0\n\tv_mbcnt_hi_u32_b32 %0, -1, %0" : "=&v"(t)); return t + (w << 6); }
__device__ __forceinline__ float bf2f(bf16_t v) { return __uint_as_float(((unsigned)v) << 16); }
__device__ __forceinline__ unsigned cvt_pk_bf16(float lo, float hi) { unsigned r; asm volatile("v_cvt_pk_bf16_f32 %0, %1, %2" : "=v"(r) : "v"(lo), "v"(hi)); return r; }
__device__ __forceinline__ bf16_t f2bf(float f) { return (bf16_t)(cvt_pk_bf16(f, 0.f) & 0xffffu); }
__device__ __forceinline__ float shfl_xor_l(float v, int lane, int o) { return __int_as_float(__builtin_amdgcn_ds_bpermute((lane ^ o) << 2, __float_as_int(v))); }
__device__ __forceinline__ float wave_sum(float v, int lane) {
#pragma unroll
    for (int o = 1; o < 64; o <<= 1) v += shfl_xor_l(v, lane, o);
    return v;
}
__device__ __forceinline__ float half_sum32(float v, int lane) {
#pragma unroll
    for (int o = 1; o < 32; o <<= 1) v += shfl_xor_l(v, lane, o);
    return v;
}
__device__ __forceinline__ unsigned pk4_fp8(float a, float b, float c, float d) { int w = 0; w = __builtin_amdgcn_cvt_pk_fp8_f32(a, b, w, false); w = __builtin_amdgcn_cvt_pk_fp8_f32(c, d, w, true); return (unsigned)w; }
__device__ __forceinline__ f32x4 fp8x4_to_f4(unsigned w) { const f32x2 lo = __builtin_amdgcn_cvt_pk_f32_fp8((int)w, false), hi = __builtin_amdgcn_cvt_pk_f32_fp8((int)w, true); return (f32x4){lo[0], lo[1], hi[0], hi[1]}; }
__device__ __forceinline__ float silu_f(float g) { return g * __builtin_amdgcn_rcpf(1.0f + __builtin_amdgcn_exp2f(-g * LOG2E)); }
__device__ __forceinline__ f32x4 bf4_to_f4(u32x2 a) { f32x4 r; r[0] = __uint_as_float(a.x << 16); r[1] = __uint_as_float(a.x & 0xffff0000u); r[2] = __uint_as_float(a.y << 16); r[3] = __uint_as_float(a.y & 0xffff0000u); return r; }

#define XB_TMO      128
#define XB_XCNT(j)  (256  + 64 * (j))
#define XB_XSUB(j)  (1280 + 64 * (j))
#define XB_XGEN(j)  (2304 + 64 * (j))
#define XB_TOP      3328
#define XB_TOPGEN   3392
#define XCD_BAR_WORDS 3456
#define XB_SPIN_CAP (1u << 18)
__device__ __forceinline__ unsigned xb_ld(unsigned* p)              { return __hip_atomic_load(p, __ATOMIC_RELAXED, __HIP_MEMORY_SCOPE_AGENT); }
__device__ __forceinline__ unsigned xb_add(unsigned* p, unsigned v) { return __hip_atomic_fetch_add(p, v, __ATOMIC_RELAXED, __HIP_MEMORY_SCOPE_AGENT); }
__device__ __forceinline__ unsigned xb_xcc_id() { return (unsigned)__builtin_amdgcn_s_getreg((3 << 11) | 20) & 0xFu; }
#define XB_SPIN(cond, bar) do { unsigned _sp = 0; while (cond) { __builtin_amdgcn_s_sleep(1); \
    if ((++_sp & 255u) == 0u) { if (xb_ld(&(bar)[XB_TMO])) break; if (_sp > XB_SPIN_CAP) { atomicAdd(&(bar)[XB_TMO], 1u); break; } } } } while (0)
struct XcdBarrier { unsigned* bar; unsigned x; volatile LAS unsigned* st; };
__device__ __forceinline__ XcdBarrier xcd_barrier_post(unsigned* bar, volatile LAS unsigned* st) {
    XcdBarrier b; b.bar = bar; b.x = xb_xcc_id(); b.st = st;
    if (threadIdx.x == 0) (void)xb_add(&bar[XB_XCNT(b.x)], 1u);
    return b;
}
__device__ __forceinline__ void xcd_barrier_complete(unsigned* bar, unsigned x, unsigned& nloc, unsigned& nx) {
    const unsigned G = gridDim.x * gridDim.y * gridDim.z;
    unsigned sum, cnt, mine, sp = 0u;
    for (;;) {
        sum = 0u; cnt = 0u; mine = 0u;
#pragma unroll
        for (unsigned j = 0; j < 16; ++j) { const unsigned c = xb_ld(&bar[XB_XCNT(j)]); sum += c; cnt += (c > 0u) ? 1u : 0u; mine = (j == x) ? c : mine; }
        if (sum == G) break;
        __builtin_amdgcn_s_sleep(1);
        if ((++sp & 255u) == 0u) { if (xb_ld(&bar[XB_TMO])) break; if (sp > XB_SPIN_CAP) { atomicAdd(&bar[XB_TMO], 1u); break; } }
    }
    nloc = mine > 0u ? mine : 1u; nx = cnt > 0u ? cnt : 1u;
}
__device__ __forceinline__ void xcd_barrier(const XcdBarrier& b) {
    asm volatile("s_waitcnt vmcnt(0)" ::: "memory");
    __syncthreads();
    if (threadIdx.x == 0) {
        unsigned long long bv_ = (unsigned long long)b.bar; unsigned bx_ = b.x;
        asm volatile("" : "+s"(bv_), "+s"(bx_));
        unsigned* bar = (unsigned*)(GAS unsigned*)bv_;
        __builtin_amdgcn_s_waitcnt(0);
        unsigned nloc = b.st[0], nx = b.st[1];
        if (nloc == 0u) { xcd_barrier_complete(bar, bx_, nloc, nx); b.st[0] = nloc; b.st[1] = nx; }
        const unsigned old = xb_add(&bar[XB_XSUB(bx_)], 1u);
        const unsigned gen = old / nloc;
        if (old + 1u == (gen + 1u) * nloc) {
            __builtin_amdgcn_fence(__ATOMIC_RELEASE, "agent");
            asm volatile("s_waitcnt vmcnt(0)" ::: "memory");
            const unsigned og = xb_add(&bar[XB_TOP], 1u);
            const unsigned tg = og / nx;
            if (og + 1u == (tg + 1u) * nx) xb_add(&bar[XB_TOPGEN], 1u);
            else XB_SPIN(xb_ld(&bar[XB_TOPGEN]) == tg, bar);
            __builtin_amdgcn_fence(__ATOMIC_ACQUIRE, "agent");
            xb_add(&bar[XB_XGEN(bx_)], 1u);
            asm volatile("s_waitcnt vmcnt(0)" ::: "memory");
        } else {
            XB_SPIN(xb_ld(&bar[XB_XGEN(bx_)]) == gen, bar);
            __builtin_amdgcn_fence(__ATOMIC_ACQUIRE, "agent");
            asm volatile("s_waitcnt vmcnt(0)" ::: "memory");
        }
    }
    __syncthreads();
}

namespace pg8 {
constexpr int BM = 256, BK = 64, HALF = 128, HTB = HALF * BK * 2, STAGE_BYTES = 8 * HTB;
__host__ __device__ __forceinline__ int lds_byte(int r, int c) { const int st = (r >> 4) * 2 + (c >> 5), rr = r & 15, cc = c & 31, ob = rr * 64 + cc * 2; return st * 1024 + (ob ^ (((ob >> 9) & 1) << 5)); }
__host__ __device__ __forceinline__ void stage_rc(int b, int& R, int& C) { const int st = b / 1024, sb = b % 1024, swz = sb ^ (((sb >> 9) & 1) << 5); R = (st >> 1) * 16 + swz / 64; C = (st & 1) * 32 + (swz % 64) / 2; }
__host__ __device__ __forceinline__ int perm32(int rho) { const int n = rho >> 4, i = rho & 15; return 8 * (i >> 2) + 4 * n + (i & 3); }
struct Unit { int pm, pn, e, rt; };
typedef int v8i32 __attribute__((ext_vector_type(8)));
typedef int v4i32 __attribute__((ext_vector_type(4)));
__device__ __forceinline__ v8i32 cat8(bf16x8 a, bf16x8 b) { const v4i32 x = __builtin_bit_cast(v4i32, a), y = __builtin_bit_cast(v4i32, b); return __builtin_shufflevector(x, y, 0, 1, 2, 3, 4, 5, 6, 7); }

template <class Epi, class Sched, bool FP8 = false>
__device__ __forceinline__ void gemm_phase(LAS unsigned char* lds, const char* Abase, const int K, const Sched& S, const Epi& E, const int wave0) {
    const int tid = opaque_tid(wave0), wid = __builtin_amdgcn_readfirstlane(tid >> 6), lane = tid & 63, wr = wid >> 2, wc = wid & 3, fr = lane & 15, fq = lane >> 4;
    const int rowB = FP8 ? K : 2 * K;
    const int nt = rowB / (BK * 2);
    int RA[2], CA[2]; unsigned voffB[2];
#pragma unroll
    for (int i = 0; i < 2; ++i) { int R, C; stage_rc(tid * 16 + i * 8192, R, C); const int Rb = (R & ~31) + perm32(R & 31); RA[i] = R; CA[i] = C; voffB[i] = (unsigned)(Rb * rowB + C * 2); }
    const size_t kstep = (size_t)(BK * 2);
    const size_t hstep = (size_t)HALF * rowB;
    const unsigned ldsw = (unsigned)wid * 1024u;
    const int aoff = lds_byte(wr * 64 + fr, fq * 8), boff = lds_byte(wc * 32 + fr, fq * 8);
#define PG8_SA(b, h) (((b) * 2 + (h)) * HTB)
#define PG8_SB(b, h) ((4 + (b) * 2 + (h)) * HTB)
#define PG8_STAGE_B(bufoff, gbase) do { _Pragma("unroll") for (int _i = 0; _i < 2; ++_i) \
        __builtin_amdgcn_global_load_lds((const unsigned*)((const char*)(gbase) + voffB[_i]), (LAS unsigned*)(lds + (bufoff) + ldsw + _i * 8192), 16, 0, 0); } while (0)
#define PG8_STAGE_A(bufoff, offs, kb) do { _Pragma("unroll") for (int _i = 0; _i < 2; ++_i) \
        __builtin_amdgcn_global_load_lds((const unsigned*)((Abase + (size_t)(unsigned)(kb)) + (offs)[_i]), (LAS unsigned*)(lds + (bufoff) + ldsw + _i * 8192), 16, 0, 0); } while (0)
#define PG8_LDA(dst, b, h) do { if constexpr (FP8) { _Pragma("unroll") for (int m = 0; m < 4; ++m) dst##8[m] = __builtin_shufflevector(*(const LAS v4i32*)(lds + PG8_SA(b, h) + aoff + m * 2048), *(const LAS v4i32*)(lds + PG8_SA(b, h) + aoff + m * 2048 + 1024), 0, 1, 2, 3, 4, 5, 6, 7); } \
    else { _Pragma("unroll") for (int m = 0; m < 4; ++m) _Pragma("unroll") for (int k = 0; k < 2; ++k) dst[m][k] = *(const LAS bf16x8*)(lds + PG8_SA(b, h) + aoff + m * 2048 + k * 1024); } } while (0)
#define PG8_LDB(dst, b, h) do { if constexpr (FP8) { _Pragma("unroll") for (int n = 0; n < 2; ++n) dst##8[n] = __builtin_shufflevector(*(const LAS v4i32*)(lds + PG8_SB(b, h) + boff + n * 2048), *(const LAS v4i32*)(lds + PG8_SB(b, h) + boff + n * 2048 + 1024), 0, 1, 2, 3, 4, 5, 6, 7); } \
    else { _Pragma("unroll") for (int n = 0; n < 2; ++n) _Pragma("unroll") for (int k = 0; k < 2; ++k) dst[n][k] = *(const LAS bf16x8*)(lds + PG8_SB(b, h) + boff + n * 2048 + k * 1024); } } while (0)
#define PG8_MMA(ai, bj, At, Bt) do { __builtin_amdgcn_s_setprio(1); _Pragma("unroll") for (int m = 0; m < 4; ++m) _Pragma("unroll") for (int n = 0; n < 2; ++n) { \
        if constexpr (FP8) asm volatile("v_mfma_scale_f32_16x16x128_f8f6f4 %0, %1, %2, %0, %3, %3 op_sel_hi:[0,0,0]" : "+v"(acc[ai][bj][m][n]) : "v"(Bt##8[n]), "v"(At##8[m]), "v"(sc1));   \
        else { _Pragma("unroll") for (int k = 0; k < 2; ++k) acc[ai][bj][m][n] = __builtin_amdgcn_mfma_f32_16x16x32_bf16(Bt[n][k], At[m][k], acc[ai][bj][m][n], 0, 0, 0); } } __builtin_amdgcn_s_setprio(0); } while (0)
#define PG8_WAIT_V(n) asm volatile("s_waitcnt vmcnt(" #n ")" ::: "memory")
#define PG8_WAIT_L(n) asm volatile("s_waitcnt lgkmcnt(" #n ")" ::: "memory")
#define PG8_BAR __builtin_amdgcn_s_barrier()
#define PG8_SCHED __builtin_amdgcn_sched_barrier(0)
    Unit cur, nxt; int ui = 0;
    if (!S.next(0, cur)) return;
    f32x4 acc[2][2][4][2];
#pragma unroll
    for (int a = 0; a < 2; ++a)
#pragma unroll
        for (int b = 0; b < 2; ++b)
#pragma unroll
            for (int m = 0; m < 4; ++m)
#pragma unroll
                for (int n = 0; n < 2; ++n) acc[a][b][m][n] = (f32x4){0.f, 0.f, 0.f, 0.f};
    bf16x8 At[4][2], B0[2][2], B1[2][2];
    int sc1 = 0x7F7F7F7F; asm volatile("" : "+v"(sc1));
    v8i32 At8[4], B08[2], B18[2];
    (void)At; (void)B0; (void)B1; (void)At8; (void)B08; (void)B18; (void)sc1;
    unsigned cA0[2], cA1[2], nA0[2], nA1[2];
    S.a_offs(cur, RA, CA, rowB, cA0, cA1);
    const char* cB = S.b_ptr(cur);
    PG8_STAGE_B(PG8_SB(0, 0), cB); PG8_STAGE_B(PG8_SB(0, 1), cB + hstep); PG8_STAGE_A(PG8_SA(0, 0), cA0, 0); PG8_STAGE_A(PG8_SA(0, 1), cA1, 0);
    if (wr == 1) PG8_BAR;
    PG8_WAIT_V(2); PG8_BAR;
    PG8_STAGE_B(PG8_SB(1, 0), cB + kstep); PG8_STAGE_A(PG8_SA(1, 0), cA0, kstep); PG8_STAGE_B(PG8_SB(1, 1), cB + hstep + kstep);
    PG8_WAIT_V(6); PG8_BAR;
    for (;;) {
        const bool has_next = S.next(ui + 1, nxt);
        const char* nB = cB;
        if (has_next) { S.a_offs(nxt, RA, CA, rowB, nA0, nA1); nB = S.b_ptr(nxt); }
        else { nA0[0] = cA0[0]; nA0[1] = cA0[1]; nA1[0] = cA1[0]; nA1[1] = cA1[1]; }
#pragma nounroll
        for (int t = 0; t < nt; t += 2) {
            const bool last = (t == nt - 2);
            const unsigned k1 = (unsigned)(t + 1) * (unsigned)kstep;
            unsigned o20[2], o21[2];
            o20[0] = last ? nA0[0] : cA0[0]; o20[1] = last ? nA0[1] : cA0[1]; o21[0] = last ? nA1[0] : cA1[0]; o21[1] = last ? nA1[1] : cA1[1];
            const unsigned k2 = last ? 0u : (unsigned)(t + 2) * (unsigned)kstep, k3 = k2 + (unsigned)kstep;
            const char* b2 = last ? nB : cB + (size_t)(t + 2) * kstep; const char* b3 = b2 + kstep;
            PG8_LDB(B0, 0, 0); PG8_LDB(B1, 0, 1); PG8_SCHED; PG8_LDA(At, 0, 0); PG8_STAGE_A(PG8_SA(1, 1), cA1, k1);
            PG8_WAIT_V(8); PG8_WAIT_L(0); PG8_BAR; PG8_MMA(0, 0, At, B0); PG8_MMA(0, 1, At, B1); PG8_BAR; PG8_SCHED;
            PG8_LDA(At, 0, 1); PG8_STAGE_B(PG8_SB(0, 0), b2); PG8_STAGE_B(PG8_SB(0, 1), b2 + hstep); PG8_STAGE_A(PG8_SA(0, 0), o20, k2);
            PG8_WAIT_V(8); PG8_WAIT_L(0); PG8_BAR; PG8_MMA(1, 0, At, B0); PG8_MMA(1, 1, At, B1); PG8_BAR; PG8_SCHED;
            PG8_LDB(B0, 1, 0); PG8_LDB(B1, 1, 1); PG8_SCHED; PG8_LDA(At, 1, 0); PG8_STAGE_A(PG8_SA(0, 1), o21, k2);
            PG8_WAIT_V(8); PG8_WAIT_L(0); PG8_BAR; PG8_MMA(0, 0, At, B0); PG8_MMA(0, 1, At, B1); PG8_BAR; PG8_SCHED;
            PG8_LDA(At, 1, 1); PG8_STAGE_B(PG8_SB(1, 0), b3); PG8_STAGE_B(PG8_SB(1, 1), b3 + hstep); PG8_STAGE_A(PG8_SA(1, 0), o20, k3);
            PG8_WAIT_V(8); PG8_WAIT_L(0); PG8_BAR; PG8_MMA(1, 0, At, B0); PG8_MMA(1, 1, At, B1); PG8_BAR; PG8_SCHED;
        }
        if (wr == 0) PG8_BAR;
        if constexpr (FP8) asm volatile("s_nop 15\n\ts_nop 15" ::: "memory");
        E(acc, cur, wr, wc, fr, fq);
        if (!has_next) break;
#pragma unroll
        for (int a = 0; a < 2; ++a)
#pragma unroll
            for (int b = 0; b < 2; ++b)
#pragma unroll
                for (int m = 0; m < 4; ++m)
#pragma unroll
                    for (int n = 0; n < 2; ++n) acc[a][b][m][n] = (f32x4){0.f, 0.f, 0.f, 0.f};
        cur = nxt; cB = nB; cA0[0] = nA0[0]; cA0[1] = nA0[1]; cA1[0] = nA1[0]; cA1[1] = nA1[1]; ++ui;
        if (wr == 1) PG8_BAR;
    }
    PG8_WAIT_V(0);
    PG8_BAR;
#undef PG8_SA
#undef PG8_SB
#undef PG8_STAGE_A
#undef PG8_STAGE_B
#undef PG8_LDA
#undef PG8_LDB
#undef PG8_MMA
#undef PG8_WAIT_V
#undef PG8_WAIT_L
#undef PG8_BAR
#undef PG8_SCHED
}

struct DenseSched {
    int nM, nN, nwg, G, c; const char* Bt; int K; bool skip_ctx;
    __device__ __forceinline__ void init(int M_, int N_, int K_, int G_, int c_, const void* Bt_, bool skip, int esz = 2) { nM = M_ / BM; nN = N_ / BM; nwg = nM * nN; G = G_; c = c_; Bt = (const char*)Bt_; K = esz * K_  ; skip_ctx = skip; if (skip) { nM = nM / 17 * 16; nwg = nM * nN; } }
    __device__ __forceinline__ bool next(int i, Unit& u) const {
        const long Lx = (long)i * G + c; if (Lx >= nwg) return false;
        int wgid = (int)Lx; { const int q = nwg / 8, r = nwg % 8, xcd = wgid % 8, off = wgid / 8; wgid = (xcd < r ? xcd * (q + 1) : r * (q + 1) + (xcd - r) * q) + off; }
        const int nig = 8 * nN, gid = wgid / nig, fm = gid * 8, gsz = (nM - fm) < 8 ? (nM - fm) : 8;
        int pm = fm + ((wgid % nig) % gsz); u.pn = (wgid % nig) / gsz;
        if (skip_ctx) pm = pm + pm / 16 + 1;
        u.pm = pm; u.e = 0; u.rt = 0; return true;
    }
    __device__ __forceinline__ void a_offs(const Unit& u, const int (&RA)[2], const int (&CA)[2], int rowB, unsigned (&o0)[2], unsigned (&o1)[2]) const {
#pragma unroll
        for (int i = 0; i < 2; ++i) { o0[i] = (unsigned)((u.pm * BM + RA[i]) * rowB + CA[i] * 2); o1[i] = (unsigned)((u.pm * BM + HALF + RA[i]) * rowB + CA[i] * 2); }
    }
    __device__ __forceinline__ const char* b_ptr(const Unit& u) const { return Bt + (size_t)u.pn * BM * K; }
};
struct OneSched {
    int pm, pn; const char* Bt; int K  ;
    __device__ __forceinline__ bool next(int i, Unit& u) const { if (i > 0) return false; u.pm = pm; u.pn = pn; u.e = 0; u.rt = 0; return true; }
    __device__ __forceinline__ void a_offs(const Unit& u, const int (&RA)[2], const int (&CA)[2], int rowB, unsigned (&o0)[2], unsigned (&o1)[2]) const {
#pragma unroll
        for (int i = 0; i < 2; ++i) { o0[i] = (unsigned)((u.pm * BM + RA[i]) * rowB + CA[i] * 2); o1[i] = (unsigned)((u.pm * BM + HALF + RA[i]) * rowB + CA[i] * 2); }
    }
    __device__ __forceinline__ const char* b_ptr(const Unit& u) const { return Bt + (size_t)u.pn * BM * K; }
};
template <bool GATHER>
struct MoeSched {
    int G, c, nN, K  ; const char* Bt; size_t estride; const LAS int* tp; const LAS int* cnt; const int* tok;
    __device__ __forceinline__ bool next(int i, Unit& u) const {
        const int Lx = i * G + c; const int ntile = tp[16];
        if (Lx >= ntile * nN) return false;
        const int pm = Lx / nN; u.pn = Lx - pm * nN; u.pm = pm;
        int e = 0;
#pragma unroll
        for (int j = 1; j < 16; ++j) e += (pm >= tp[j]) ? 1 : 0;
        u.e = e; u.rt = pm - tp[e]; return true;
    }
    __device__ __forceinline__ void a_offs(const Unit& u, const int (&RA)[2], const int (&CA)[2], int rowB, unsigned (&o0)[2], unsigned (&o1)[2]) const {
        if (GATHER) {
            const int n = cnt[u.e];
#pragma unroll
            for (int i = 0; i < 2; ++i) {
                const int p0 = u.rt * BM + RA[i], p1 = p0 + HALF;
                const int t0 = p0 < n ? tok[(size_t)u.e * CAP + p0] : 0, t1 = p1 < n ? tok[(size_t)u.e * CAP + p1] : 0;
                o0[i] = (unsigned)((t0 >> 1) * rowB + CA[i] * 2); o1[i] = (unsigned)((t1 >> 1) * rowB + CA[i] * 2);
            }
        } else {
#pragma unroll
            for (int i = 0; i < 2; ++i) { o0[i] = (unsigned)((u.pm * BM + RA[i]) * rowB + CA[i] * 2); o1[i] = (unsigned)((u.pm * BM + HALF + RA[i]) * rowB + CA[i] * 2); }
        }
    }
    __device__ __forceinline__ const char* b_ptr(const Unit& u) const { return Bt + (size_t)u.e * estride + (size_t)u.pn * BM * K; }
};

constexpr float WSCALE = 32.0f, WINV = 1.0f / 32.0f;
#define EPI_ARGS const f32x4 (&acc)[2][2][4][2], const Unit& u, int wr, int wc, int fr, int fq
__device__ __forceinline__ u32x4 pack8(f32x4 a, f32x4 b) { u32x4 w; w.x = cvt_pk_bf16(a[0], a[1]); w.y = cvt_pk_bf16(a[2], a[3]); w.z = cvt_pk_bf16(b[0], b[1]); w.w = cvt_pk_bf16(b[2], b[3]); return w; }
__device__ __forceinline__ unsigned char* qk8_ptr(unsigned char* QK8, int pm, int lr, int pn, int wc, int fq, int bj) {
    if (pn < 2) return QK8 + (size_t)(pm * BM + lr) * 1024 + pn * BM + wc * 32 + 8 * fq + bj * HALF;
    asm volatile("" : "+v"(lr));
    const int b = pm / 17, tb = pm - b * 17, h = (pn - 2) * 2 + bj;
    return QK8 + K8T_OFF + ((size_t)((b * 4 + h) * (LT / 64) + tb * 4 + (lr >> 6)) * 64 + (lr & 63)) * 128 + wc * 32 + 8 * fq;
}
struct EpiG1 {
    bf16_t* P; const float* ropec; const float* ropes; unsigned char* QK8;
    __device__ __forceinline__ void operator()(EPI_ARGS) const {
        const int pn = u.pn, tb = u.pm % 17;
        const bool rope = (tb != 0) && (pn < 4 || pn == 7 || pn == 8);
        const bool qk8 = pn < 4;
        const float sc = WINV * ((pn == 8) ? 0.125f : (pn < 2 ? 0.125f * 1.4426950408889634f * 4.0f : (pn < 4 ? 0.25f : 1.0f)));
        const int axis = wc & 1;
        if (rope) {
#pragma unroll
            for (int ai = 0; ai < 2; ++ai)
#pragma unroll
                for (int m = 0; m < 4; ++m) {
                    const int lr = ai * HALF + wr * 64 + m * 16 + fr;
                    const int gr = (tb - 1) * 4 + (lr >> 6), gc = lr & 63; const int pos = axis ? gc : gr;
                    f32x4 cs0 = *(const f32x4*)(ropec + pos * 16 + 4 * fq), sn0 = *(const f32x4*)(ropes + pos * 16 + 4 * fq);
                    cs0 = cs0 * sc; sn0 = sn0 * sc;
                    bf16_t* rowp = P + (size_t)(u.pm * BM + lr) * INW + pn * BM + wc * 32 + 8 * fq;
#pragma unroll
                    for (int bj = 0; bj < 2; ++bj) {
                        const f32x4 v0 = acc[ai][bj][m][0], v1 = acc[ai][bj][m][1];
                        f32x4 r0, r1;
                        r0[0] = v0[0] * cs0[0] - v0[1] * sn0[0]; r0[1] = v0[1] * cs0[0] + v0[0] * sn0[0];
                        r0[2] = v0[2] * cs0[1] - v0[3] * sn0[1]; r0[3] = v0[3] * cs0[1] + v0[2] * sn0[1];
                        r1[0] = v1[0] * cs0[2] - v1[1] * sn0[2]; r1[1] = v1[1] * cs0[2] + v1[0] * sn0[2];
                        r1[2] = v1[2] * cs0[3] - v1[3] * sn0[3]; r1[3] = v1[3] * cs0[3] + v1[2] * sn0[3];
                        if (qk8) { u32x2 w8; w8.x = pk4_fp8(r0[0], r0[1], r0[2], r0[3]); w8.y = pk4_fp8(r1[0], r1[1], r1[2], r1[3]); *(u32x2*)qk8_ptr(QK8, u.pm, lr, pn, wc, fq, bj) = w8; }
                        else *(u32x4*)(rowp + bj * HALF) = pack8(r0, r1);
                    }
                    if (m & 1) asm volatile("" ::: "memory");
                }
        } else {
#pragma unroll
            for (int ai = 0; ai < 2; ++ai)
#pragma unroll
                for (int m = 0; m < 4; ++m) {
                    const int lr = ai * HALF + wr * 64 + m * 16 + fr;
                    bf16_t* rowp = P + (size_t)(u.pm * BM + lr) * INW + pn * BM + wc * 32 + 8 * fq;
#pragma unroll
                    for (int bj = 0; bj < 2; ++bj) { const f32x4 a0 = acc[ai][bj][m][0] * sc, a1 = acc[ai][bj][m][1] * sc;
                        if (qk8) { u32x2 w8; w8.x = pk4_fp8(a0[0], a0[1], a0[2], a0[3]); w8.y = pk4_fp8(a1[0], a1[1], a1[2], a1[3]); *(u32x2*)qk8_ptr(QK8, u.pm, lr, pn, wc, fq, bj) = w8; }
                        else *(u32x4*)(rowp + bj * HALF) = pack8(a0, a1); }
                }
        }
    }
};
struct EpiG2 {
    const float* xin_lat; const float* xin_ctx; bf16_t* XB; const float* modl; bool first;
    __device__ __forceinline__ void operator()(EPI_ARGS) const {
        const int b = u.pm / 17, tb = u.pm - b * 17;
        const bool isctx = (tb == 0);
        const float* g = modl + (size_t)(isctx ? 8 : b) * 6144 + 2048;
        const int col0 = u.pn * BM + wc * 32 + 8 * fq;
        f32x4 gv[2][2];
#pragma unroll
        for (int bj = 0; bj < 2; ++bj) { gv[bj][0] = *(const f32x4*)(g + col0 + bj * HALF); gv[bj][1] = *(const f32x4*)(g + col0 + bj * HALF + 4); }
        if (first) {
            const size_t rbase = isctx ? (size_t)b * LC : (size_t)b * L + (size_t)(tb - 1) * BM;
            const float* src = isctx ? xin_ctx : xin_lat;
#pragma unroll
            for (int ai = 0; ai < 2; ++ai) {
                f32x4 o[4][2][2];
#pragma unroll
                for (int m = 0; m < 4; ++m) { const size_t off = (rbase + ai * HALF + wr * 64 + m * 16 + fr) * D + col0;
#pragma unroll
                    for (int bj = 0; bj < 2; ++bj) { o[m][bj][0] = *(const f32x4*)(src + off + bj * HALF); o[m][bj][1] = *(const f32x4*)(src + off + bj * HALF + 4); } }
                asm volatile("" ::: "memory");
#pragma unroll
                for (int m = 0; m < 4; ++m) { bf16_t* dp = XB + (size_t)(u.pm * BM + ai * HALF + wr * 64 + m * 16 + fr) * D + col0;
#pragma unroll
                    for (int bj = 0; bj < 2; ++bj) *(u32x4*)(dp + bj * HALF) = pack8(o[m][bj][0] + gv[bj][0] * acc[ai][bj][m][0], o[m][bj][1] + gv[bj][1] * acc[ai][bj][m][1]); }
                asm volatile("" ::: "memory");
            }
        } else {
#pragma unroll
            for (int ai = 0; ai < 2; ++ai) {
                u32x4 o[4][2];
#pragma unroll
                for (int m = 0; m < 4; ++m) { const bf16_t* sp = XB + (size_t)(u.pm * BM + ai * HALF + wr * 64 + m * 16 + fr) * D + col0;
#pragma unroll
                    for (int bj = 0; bj < 2; ++bj) o[m][bj] = *(const u32x4*)(sp + bj * HALF); }
                asm volatile("" ::: "memory");
#pragma unroll
                for (int m = 0; m < 4; ++m) { bf16_t* dp = XB + (size_t)(u.pm * BM + ai * HALF + wr * 64 + m * 16 + fr) * D + col0;
#pragma unroll
                    for (int bj = 0; bj < 2; ++bj) { const u32x4 w = o[m][bj];
                        const f32x4 x0 = bf4_to_f4((u32x2){w.x, w.y}), x1 = bf4_to_f4((u32x2){w.z, w.w});
                        *(u32x4*)(dp + bj * HALF) = pack8(x0 + gv[bj][0] * acc[ai][bj][m][0], x1 + gv[bj][1] * acc[ai][bj][m][1]); } }
                asm volatile("" ::: "memory");
            }
        }
    }
};
constexpr float YSCALE = 16.0f, YINV = 1.0f / 16.0f;
struct EpiE1 {
    unsigned char* ACT;
    __device__ __forceinline__ void operator()(EPI_ARGS) const {
        const int col0 = 8 * ((u.pn * 4 + wc) * 4 + fq);
#pragma unroll
        for (int ai = 0; ai < 2; ++ai)
#pragma unroll
            for (int m = 0; m < 4; ++m) {
                const int lr = ai * HALF + wr * 64 + m * 16 + fr;
                u32x2 w;
                { const f32x4 g = acc[ai][0][m][0] * WINV, up = acc[ai][0][m][1] * WINV; w.x = pk4_fp8(silu_f(g[0]) * up[0], silu_f(g[1]) * up[1], silu_f(g[2]) * up[2], silu_f(g[3]) * up[3]); }
                { const f32x4 g = acc[ai][1][m][0] * WINV, up = acc[ai][1][m][1] * WINV; w.y = pk4_fp8(silu_f(g[0]) * up[0], silu_f(g[1]) * up[1], silu_f(g[2]) * up[2], silu_f(g[3]) * up[3]); }
                *(u32x2*)(ACT + (size_t)(u.pm * BM + lr) * DE + col0) = w;
            }
    }
};
struct EpiE2 {
    unsigned char* Y2; const int* tok; const float* gate; const LAS int* cnt;
    __device__ __forceinline__ void operator()(EPI_ARGS) const {
        const int n = cnt[u.e];
        const int col0 = u.pn * BM + wc * 32 + 8 * fq;
        int pr[8]; float gt[8];
#pragma unroll
        for (int q = 0; q < 8; ++q) { const int pos = u.rt * BM + (q >> 2) * HALF + wr * 64 + (q & 3) * 16 + fr; pr[q] = pos < n ? tok[(size_t)u.e * CAP + pos] : -1; }
#pragma unroll
        for (int q = 0; q < 8; ++q) gt[q] = pr[q] >= 0 ? gate[pr[q]] * (WINV * YSCALE) : 0.f;
#pragma unroll
        for (int q = 0; q < 8; ++q) {
            if (pr[q] >= 0) {
                unsigned char* rowp = Y2 + (size_t)pr[q] * D + col0;
#pragma unroll
                for (int bj = 0; bj < 2; ++bj) { const f32x4 a0 = acc[q >> 2][bj][q & 3][0] * gt[q], a1 = acc[q >> 2][bj][q & 3][1] * gt[q];
                    u32x2 w; w.x = pk4_fp8(a0[0], a0[1], a0[2], a0[3]); w.y = pk4_fp8(a1[0], a1[1], a1[2], a1[3]); *(u32x2*)(rowp + bj * HALF) = w; }
            }
        }
    }
};
}

namespace att {
constexpr int NW = 8, QBLK = 32, KVBLK = 64;
constexpr float SCALE = 0.125f;
constexpr float THR = 8.f;
constexpr int NBUF = 3;
constexpr size_t SHM_V = KVBLK * 128 * 2, SHM_K = KVBLK * 128 * 2, SHM_ATTN = NBUF * SHM_V + NBUF * SHM_K + NW * 64 * 4;
#define KSWZ(row, colB) ((row) * 256 + ((colB) ^ (((row) & 7) << 4)))
#define SBAR() __builtin_amdgcn_sched_barrier(0)
__device__ __forceinline__ int crow(int r, int hi) { return (r & 3) + 8 * (r >> 2) + 4 * hi; }
__device__ __forceinline__ unsigned cvtpk(float lo, float hi) { unsigned r; asm volatile("v_cvt_pk_bf16_f32 %0, %1, %2" : "=v"(r) : "v"(lo), "v"(hi)); return r; }
__device__ __forceinline__ bf16x8 ld8(const bf16_t* p) { return *reinterpret_cast<const bf16x8*>(p); }

constexpr float C2 = SCALE * 1.4426950408889634f;
constexpr float THR2 = THR * 1.4426950408889634f;
__device__ __forceinline__ void partialSM(f32x16& p0, f32x16& p1, float& mhat, f32x16& negm, float& alpha) {
  float pmax = p0[0];
#pragma unroll
  for (int r = 1; r < 16; ++r) pmax = fmaxf(pmax, p0[r]);
#pragma unroll
  for (int r = 0; r < 16; ++r) pmax = fmaxf(pmax, p1[r]);
  { auto rr = __builtin_amdgcn_permlane32_swap(__float_as_uint(pmax), __float_as_uint(pmax), false, false);
    pmax = fmaxf(__uint_as_float(rr[0]), __uint_as_float(rr[1])); }
  if (__builtin_expect(__all(pmax <= THR2), 1)) { alpha = 1.f; }
  else { const float dl = fmaxf(pmax, 0.f); mhat += dl;
#pragma unroll
    for (int r = 0; r < 16; ++r) { p0[r] -= dl; p1[r] -= dl; }
#pragma unroll
    for (int r = 0; r < 16; ++r) negm[r] = -mhat;
    alpha = __builtin_amdgcn_exp2f(-dl); }
#pragma unroll
  for (int r = 0; r < 16; ++r) p0[r] = __builtin_amdgcn_exp2f(p0[r]);
}
#define PK4(P, BASE, OUT) do { unsigned a0 = cvtpk(P[BASE + 0], P[BASE + 1]), a1 = cvtpk(P[BASE + 2], P[BASE + 3]);   \
    unsigned b0 = cvtpk(P[BASE + 4], P[BASE + 5]), b1 = cvtpk(P[BASE + 6], P[BASE + 7]);                              \
    auto r0 = __builtin_amdgcn_permlane32_swap(a0, b0, false, false); auto r1 = __builtin_amdgcn_permlane32_swap(a1, b1, false, false); \
    u32x4 w = {r0[0], r1[0], r0[1], r1[1]}; OUT = *reinterpret_cast<bf16x8*>(&w); } while (0)
__device__ __forceinline__ void finishSM(f32x16& p0, f32x16& p1, float alpha, float& l_reg, bf16x8& pa0, bf16x8& pa1, bf16x8& pa2, bf16x8& pa3) {
#pragma unroll
  for (int r = 0; r < 16; ++r) p1[r] = __builtin_amdgcn_exp2f(p1[r]);
  float ps = 0;
#pragma unroll
  for (int r = 0; r < 16; ++r) ps += p0[r];
#pragma unroll
  for (int r = 0; r < 16; ++r) ps += p1[r];
  { auto rr = __builtin_amdgcn_permlane32_swap(__float_as_uint(ps), __float_as_uint(ps), false, false);
    ps = __uint_as_float(rr[0]) + __uint_as_float(rr[1]); }
  l_reg = l_reg * alpha + ps;
  PK4(p0, 0, pa0); PK4(p0, 8, pa1); PK4(p1, 0, pa2); PK4(p1, 8, pa3);
}
__device__ __forceinline__ void qkt(f32x16& p0, f32x16& p1, const bf16_t* Ks, const bf16x8* qr, int r32, int hi, int dbase, const f32x16& negm) {
#pragma unroll
  for (int d0 = 0; d0 < 4; ++d0) { int cb = (dbase + d0 * 16 + hi * 8) * 2;
    bf16x8 b0 = *reinterpret_cast<const bf16x8*>((const char*)Ks + KSWZ(r32, cb));
    bf16x8 b1 = *reinterpret_cast<const bf16x8*>((const char*)Ks + KSWZ(32 + r32, cb));
    if (d0 == 0) { p0 = __builtin_amdgcn_mfma_f32_32x32x16_bf16(b0, qr[0], negm, 0, 0, 0); p1 = __builtin_amdgcn_mfma_f32_32x32x16_bf16(b1, qr[0], negm, 0, 0, 0); }
    else { p0 = __builtin_amdgcn_mfma_f32_32x32x16_bf16(b0, qr[d0], p0, 0, 0, 0); p1 = __builtin_amdgcn_mfma_f32_32x32x16_bf16(b1, qr[d0], p1, 0, 0, 0); } }
}
template <int CPT> __device__ __forceinline__ int v_st(int k, int c) { const int kk = (k & ~0xC) | ((k & 4) << 1) | ((k & 8) >> 1); return ((kk >> 3) * CPT + (c >> 5)) * 512 + ((kk & 7) * 32 + (c & 31)) * 2; }
__device__ __forceinline__ int v_rd_base(int lane) { return ((lane & 3) << 3) | (((lane >> 2) & 3) << 6) | (((lane >> 4) & 1) << 5) | (((lane >> 5) & 1) << 8); }
template <int CPT> constexpr int v_rd_off(int d0, int ks, int half) { return d0 * 512 + ks * (CPT * 1024) + half * (CPT * 512); }
template <int OFF> __device__ __forceinline__ s16x4 tr_read(int vb) {
  s16x4 r; asm volatile("ds_read_b64_tr_b16 %0, %1 offset:%2" : "=&v"(r) : "v"(vb), "i"(OFF) : "memory"); return r;
}
template <int CPT, int D0> __device__ __forceinline__ void pv_one(f32x16& od, int vb, bf16x8 pa0, bf16x8 pa1, bf16x8 pa2, bf16x8 pa3) {
  const s16x4 l0 = tr_read<v_rd_off<CPT>(D0, 0, 0)>(vb), h0 = tr_read<v_rd_off<CPT>(D0, 0, 1)>(vb), l1 = tr_read<v_rd_off<CPT>(D0, 1, 0)>(vb), h1 = tr_read<v_rd_off<CPT>(D0, 1, 1)>(vb);
  const s16x4 l2 = tr_read<v_rd_off<CPT>(D0, 2, 0)>(vb), h2 = tr_read<v_rd_off<CPT>(D0, 2, 1)>(vb), l3 = tr_read<v_rd_off<CPT>(D0, 3, 0)>(vb), h3 = tr_read<v_rd_off<CPT>(D0, 3, 1)>(vb);
  asm volatile("s_waitcnt lgkmcnt(0)" ::: "memory"); SBAR();
#define PK(L_, H_) (bf16x8){L_[0], L_[1], L_[2], L_[3], H_[0], H_[1], H_[2], H_[3]}
  od = __builtin_amdgcn_mfma_f32_32x32x16_bf16(pa0, PK(l0, h0), od, 0, 0, 0);
  od = __builtin_amdgcn_mfma_f32_32x32x16_bf16(pa1, PK(l1, h1), od, 0, 0, 0);
  od = __builtin_amdgcn_mfma_f32_32x32x16_bf16(pa2, PK(l2, h2), od, 0, 0, 0);
  od = __builtin_amdgcn_mfma_f32_32x32x16_bf16(pa3, PK(l3, h3), od, 0, 0, 0);
#undef PK
}
__device__ __forceinline__ void pv4(f32x16* o, int vb, bf16x8 pa0, bf16x8 pa1, bf16x8 pa2, bf16x8 pa3) {
  pv_one<4, 0>(o[0], vb, pa0, pa1, pa2, pa3); pv_one<4, 1>(o[1], vb, pa0, pa1, pa2, pa3); pv_one<4, 2>(o[2], vb, pa0, pa1, pa2, pa3); pv_one<4, 3>(o[3], vb, pa0, pa1, pa2, pa3);
}
__device__ __forceinline__ void pv2(f32x16* o, int vb, bf16x8 pa0, bf16x8 pa1, bf16x8 pa2, bf16x8 pa3) {
  pv_one<2, 0>(o[0], vb, pa0, pa1, pa2, pa3); pv_one<2, 1>(o[1], vb, pa0, pa1, pa2, pa3);
}

__device__ __forceinline__ void attn_unit(const bf16_t* __restrict__ P, int qrow0, int krow0, int seq, int h, float lam, const float* __restrict__ nw, float oscale, bf16_t* __restrict__ MIX, char* lds, const int wave0) {
  const int tid = opaque_tid(wave0), wid = tid >> 6, lane = tid & 63, r32 = lane & 31, hi = lane >> 5;
  const int map = wid >> 2, wq = wid & 3;
  bf16_t* V_lds = (bf16_t*)lds; bf16_t* K_lds = (bf16_t*)(lds + NBUF * SHM_V);
  float* ws = (float*)(lds + NBUF * SHM_V + NBUF * SHM_K) + wid * 64; float* li_l = ws; float* al_l = ws + 32;
  float m_reg = 0.f  , l_reg = 0; f32x16 o[4] = {}; bf16x8 qr[4]; f32x16 negm = {};
  const bf16_t* Qw = P + (size_t)(qrow0 + wq * QBLK + r32) * INW + OFF_DQ + h * 128 + map * 64 + hi * 8;
#pragma unroll
  for (int d0 = 0; d0 < 4; ++d0) { const bf16x8 raw = ld8(Qw + d0 * 16); u32x4 w;
#pragma unroll
    for (int z = 0; z < 4; ++z) w[z] = cvtpk(bf2f((bf16_t)raw[2 * z]) * C2, bf2f((bf16_t)raw[2 * z + 1]) * C2);
    qr[d0] = *reinterpret_cast<bf16x8*>(&w); }
  const bf16_t* Kh = P + (size_t)krow0 * INW + OFF_DK + h * 128;
  const bf16_t* Vh = P + (size_t)krow0 * INW + OFF_DV + h * 128;
  const int sr = tid >> 4, sc = (tid & 15) * 8, vst0 = v_st<4>(sr, sc), vst1 = v_st<4>(32 + sr, sc);
  const int vb0 = (int)(uintptr_t)V_lds + v_rd_base(lane);
  const int dbase = map * 64;
  struct { bf16x8 vs0, vs1, ks0, ks1; } sr_[2];
#define SLOAD(i, k0) do { sr_[i].vs0 = ld8(&Vh[(size_t)((k0) + sr) * INW + sc]); sr_[i].vs1 = ld8(&Vh[(size_t)((k0) + 32 + sr) * INW + sc]); \
    sr_[i].ks0 = ld8(&Kh[(size_t)((k0) + sr) * INW + sc]); sr_[i].ks1 = ld8(&Kh[(size_t)((k0) + 32 + sr) * INW + sc]); } while (0)
#define SWRITE(b, i) do { *(bf16x8*)((char*)V_lds + (b) * SHM_V + vst0) = sr_[i].vs0;          \
    *(bf16x8*)((char*)V_lds + (b) * SHM_V + vst1) = sr_[i].vs1; int kc = sc * 2;               \
    *(bf16x8*)((char*)K_lds + (b) * SHM_K + KSWZ(sr, kc)) = sr_[i].ks0;                       \
    *(bf16x8*)((char*)K_lds + (b) * SHM_K + KSWZ(32 + sr, kc)) = sr_[i].ks1; } while (0)
#define SWAIT() asm volatile("s_waitcnt vmcnt(4)" ::: "memory")
#define RESC(a) do { if (__any((a) < 1.f)) { if (hi == 0) al_l[r32] = (a); asm volatile("s_waitcnt lgkmcnt(0)" ::: "memory"); \
    _Pragma("unroll") for (int d = 0; d < 4; ++d) _Pragma("unroll") for (int r = 0; r < 16; ++r) o[d][r] *= al_l[crow(r, hi)]; } } while (0)
  f32x16 pA0, pA1, pB0, pB1; float alA, alB; bf16x8 pa0, pa1, pa2, pa3; const int NT = seq / KVBLK;
  constexpr int SE = 0, SO = 1;
  int bprev = 0, bcur = 1, bnext = 2;
#define KBUF(b) ((bf16_t*)((char*)K_lds + (b) * (int)SHM_K))
#define VBUF(b) (vb0 + (b) * (int)SHM_V)
#define ROT3() do { const int t_ = bprev; bprev = bcur; bcur = bnext; bnext = t_; } while (0)
  SLOAD(SE, 0); asm volatile("s_waitcnt vmcnt(0)" ::: "memory"); SWRITE(0, SE);
  SLOAD(SO, KVBLK); SLOAD(SE, 2 * KVBLK);
  __syncthreads();
  qkt(pA0, pA1, KBUF(0), qr, r32, hi, dbase, negm); partialSM(pA0, pA1, m_reg, negm, alA);
  SWAIT(); SWRITE(1, SO); __syncthreads();
  for (int j = 1; j + 1 < NT; j += 2) {
    SBAR(); qkt(pB0, pB1, KBUF(bcur), qr, r32, hi, dbase, negm);
    finishSM(pA0, pA1, alA, l_reg, pa0, pa1, pa2, pa3); SBAR();
    SLOAD(SO, (j + 2) * KVBLK); SBAR();
    pv4(o, VBUF(bprev), pa0, pa1, pa2, pa3); partialSM(pB0, pB1, m_reg, negm, alB);
    SWAIT(); SWRITE(bnext, SE);
    RESC(alB); __syncthreads(); ROT3();
    SBAR(); qkt(pA0, pA1, KBUF(bcur), qr, r32, hi, dbase, negm);
    finishSM(pB0, pB1, alB, l_reg, pa0, pa1, pa2, pa3); SBAR();
    if (j + 3 < NT) SLOAD(SE, (j + 3) * KVBLK); SBAR();
    pv4(o, VBUF(bprev), pa0, pa1, pa2, pa3); partialSM(pA0, pA1, m_reg, negm, alA);
    if (j + 3 < NT) SWAIT(); else asm volatile("s_waitcnt vmcnt(0)" ::: "memory");
    SWRITE(bnext, SO);
    RESC(alA); __syncthreads(); ROT3();
  }
  SBAR(); qkt(pB0, pB1, KBUF(bcur), qr, r32, hi, dbase, negm);
  finishSM(pA0, pA1, alA, l_reg, pa0, pa1, pa2, pa3); SBAR();
  pv4(o, VBUF(bprev), pa0, pa1, pa2, pa3); partialSM(pB0, pB1, m_reg, negm, alB);
  RESC(alB);
  finishSM(pB0, pB1, alB, l_reg, pa0, pa1, pa2, pa3); SBAR();
  pv4(o, VBUF(bcur), pa0, pa1, pa2, pa3);
#undef KBUF
#undef VBUF
#undef ROT3
  { const int tid_e = opaque_tid(wave0), lane_e = tid_e & 63; const int lane = lane_e, r32 = lane_e & 31, hi = lane_e >> 5, wid = tid_e >> 6, map = wid >> 2, wq = wid & 3; (void)map; (void)wq;
  if (hi == 0) li_l[r32] = l_reg; asm volatile("s_waitcnt lgkmcnt(0)" ::: "memory");
  float rli[16];
#pragma unroll
  for (int r = 0; r < 16; ++r) rli[r] = __builtin_amdgcn_rcpf(li_l[crow(r, hi)]);
  __syncthreads();
  float* stash = (float*)lds + wq * 4096;
  if (map == 1) {
#pragma unroll
    for (int d0 = 0; d0 < 4; ++d0)
#pragma unroll
      for (int r = 0; r < 16; ++r) stash[(d0 * 16 + r) * 64 + lane] = lam * o[d0][r] * rli[r];
  }
  __syncthreads();
  if (map == 0) {
    float rs[16];
#pragma unroll
    for (int r = 0; r < 16; ++r) {
      float ss = 0.f;
#pragma unroll
      for (int d0 = 0; d0 < 4; ++d0) { const float a = o[d0][r] * rli[r] - stash[(d0 * 16 + r) * 64 + lane]; o[d0][r] = a; ss += a * a; }
      ss = half_sum32(ss, lane);
      rs[r] = oscale / sqrtf(ss * (1.0f / 128.0f) + EPS);
    }
    float nwv[4];
#pragma unroll
    for (int d0 = 0; d0 < 4; ++d0) nwv[d0] = nw[d0 * 32 + r32];
    bf16_t* Ow = MIX + (size_t)(qrow0 + wq * QBLK) * D + h * 128;
#pragma unroll
    for (int r = 0; r < 16; ++r) { const int orow = crow(r, hi);
#pragma unroll
      for (int d0 = 0; d0 < 4; ++d0) Ow[(size_t)orow * D + d0 * 32 + r32] = f2bf(o[d0][r] * rs[r] * nwv[d0]); }
  }
  }
  __syncthreads();
#undef SLOAD
#undef SWRITE
#undef SWAIT
#undef RESC
}

typedef int v8i __attribute__((ext_vector_type(8)));
typedef int v4i __attribute__((ext_vector_type(4)));
constexpr int DIST8 = 3, NB8 = DIST8 + 2, K8B = 8192, V8B = 8192 + 2048;
__device__ __forceinline__ v8i ldsrd32(const char* p0, const char* p1) { const v4i a = *(const v4i*)p0, b = *(const v4i*)p1; return __builtin_shufflevector(a, b, 0, 1, 2, 3, 4, 5, 6, 7); }
#define MFMA8_NEW(D_, A_, B_, C_, SC_, SCB_) asm volatile("v_mfma_scale_f32_32x32x64_f8f6f4 %0, %1, %2, %3, %4, %5 op_sel_hi:[0,0,0]" : "=&v"(D_) : "v"(A_), "v"(B_), "v"(C_), "v"(SC_), "v"(SCB_))
#define MFMA8_ACC(D_, A_, B_, SC_) asm volatile("v_mfma_scale_f32_32x32x64_f8f6f4 %0, %1, %2, %0, %3, %3 op_sel_hi:[0,0,0]" : "+v"(D_) : "v"(A_), "v"(B_), "v"(SC_))
constexpr float P8_U = 1.0f / 65536.0f;
constexpr float P8_ONE = 96.0f * P8_U;
constexpr float THR8 = 28.0f * P8_U;
__device__ __forceinline__ void partialSM8(f32x16& p0, f32x16& p1, float& mhat, f32x16& negm, float& alpha) {
  float pmax = p0[0];
#pragma unroll
  for (int r = 1; r < 16; ++r) pmax = fmaxf(pmax, p0[r]);
#pragma unroll
  for (int r = 0; r < 16; ++r) pmax = fmaxf(pmax, p1[r]);
  { auto rr = __builtin_amdgcn_permlane32_swap(__float_as_uint(pmax), __float_as_uint(pmax), false, false);
    pmax = fmaxf(__uint_as_float(rr[0]), __uint_as_float(rr[1])); }
  if (__builtin_expect(__all(pmax <= P8_ONE + THR8), 1)) { alpha = 1.f; }
  else { const float dl = fmaxf(pmax - P8_ONE, 0.f); mhat += dl;
#pragma unroll
    for (int r = 0; r < 16; ++r) { p0[r] -= dl; p1[r] -= dl; }
#pragma unroll
    for (int r = 0; r < 16; ++r) negm[r] -= dl;
    alpha = __builtin_amdgcn_exp2f(-0.125f * 65536.0f * dl); }
}
__device__ __forceinline__ float max16(const f32x16& p, float m) {
  asm("v_max3_f32 %0, %0, %1, %2\n\tv_max3_f32 %0, %0, %3, %4\n\tv_max3_f32 %0, %0, %5, %6\n\tv_max3_f32 %0, %0, %7, %8\n\tv_max3_f32 %0, %0, %9, %10\n\tv_max3_f32 %0, %0, %11, %12\n\tv_max3_f32 %0, %0, %13, %14\n\tv_max3_f32 %0, %0, %15, %16"
      : "+v"(m) : "v"(p[0]), "v"(p[1]), "v"(p[2]), "v"(p[3]), "v"(p[4]), "v"(p[5]), "v"(p[6]), "v"(p[7]), "v"(p[8]), "v"(p[9]), "v"(p[10]), "v"(p[11]), "v"(p[12]), "v"(p[13]), "v"(p[14]), "v"(p[15]));
  return m;
}
__device__ __forceinline__ void decideSM8(float pmax, f32x16& p0, f32x16& p1, f32x16& negm, float& alpha) {
  if (__builtin_expect(__all(pmax <= P8_ONE + THR8), 1)) { alpha = 1.f; }
  else {
    { auto rr = __builtin_amdgcn_permlane32_swap(__float_as_uint(pmax), __float_as_uint(pmax), false, false);
      const float a_ = __uint_as_float(rr[0]), b_ = __uint_as_float(rr[1]); asm("v_max_f32 %0, %1, %2" : "=v"(pmax) : "v"(a_), "v"(b_)); }
    const float dl = fmaxf(pmax - P8_ONE, 0.f);
#pragma unroll
    for (int r = 0; r < 16; ++r) { p0[r] -= dl; p1[r] -= dl; }
#pragma unroll
    for (int r = 0; r < 16; ++r) negm[r] -= dl;
    alpha = __builtin_amdgcn_exp2f(-0.125f * 65536.0f * dl); }
}
typedef unsigned short us2_t __attribute__((ext_vector_type(2)));
__device__ __forceinline__ unsigned pk4_u8(float a, float b, float c, float d) {
  const us2_t w0 = __builtin_amdgcn_cvt_pknorm_u16(a, b), w1 = __builtin_amdgcn_cvt_pknorm_u16(c, d);
  return __builtin_amdgcn_perm(__builtin_bit_cast(unsigned, w1), __builtin_bit_cast(unsigned, w0), 0x06040200u); }
__device__ __forceinline__ void finishSM8(f32x16& p0, f32x16& p1, v8i& pa) {
#pragma unroll
  for (int g = 0; g < 4; ++g) { pa[g] = (int)pk4_u8(p0[4 * g], p0[4 * g + 1], p0[4 * g + 2], p0[4 * g + 3]); pa[4 + g] = (int)pk4_u8(p1[4 * g], p1[4 * g + 1], p1[4 * g + 2], p1[4 * g + 3]); }
}
__device__ __forceinline__ void qkt8(f32x16& p0, f32x16& p1, const char* Kb, const v8i& q8, int r32, int hi, int map, const f32x16& negm, int sc1, int sc8) {
  const int c0 = 4 * map + 2 * hi;
  const int sw0 = (r32 >> 1) & 7;
  const char* ra = Kb + r32 * 128; const char* rb = Kb + (32 + r32) * 128;
  const v8i k0 = ldsrd32(ra + ((c0 ^ sw0) << 4), ra + (((c0 + 1) ^ sw0) << 4));
  const v8i k1 = ldsrd32(rb + ((c0 ^ sw0) << 4), rb + (((c0 + 1) ^ sw0) << 4));
  MFMA8_NEW(p0, k0, q8, negm, sc1, sc8);
  MFMA8_NEW(p1, k1, q8, negm, sc1, sc8);
  asm volatile("s_nop 15\n\ts_nop 15" : "+v"(p0), "+v"(p1));
}
__device__ __forceinline__ void pv8(f32x16* o, const char* Vb, const v8i& pa, int r32, int hi, int sc1) {
  asm volatile("s_nop 4" ::: "memory");
#pragma unroll
  for (int eb = 0; eb < 5; ++eb) { const int e = 32 * eb + r32; const int sw = (e >> 2) & 3; const char* rp = Vb + e * 64;
    const v8i vf = ldsrd32(rp + (((2 * hi) ^ sw) << 4), rp + (((2 * hi + 1) ^ sw) << 4));
    MFMA8_ACC(o[eb], pa, vf, sc1); }
}
__device__ __forceinline__ void attn_unit8(const unsigned char* __restrict__ QK8, const unsigned char* __restrict__ VT8, int qrow0, int krow0, int seq, int bh, int h, float lam, const float* __restrict__ nw, float oscale, bf16_t* __restrict__ MIX, char* lds, const int wave0) {
  const int tid = opaque_tid(wave0), wid = tid >> 6, lane = tid & 63, r32 = lane & 31, hi = lane >> 5;
  const int map = wid >> 2, wq = wid & 3;
  char* V_lds = lds; char* K_lds = lds + NB8 * V8B;
  float* ws = (float*)(lds + NB8 * V8B + NB8 * K8B) + wid * 64; float* al_l = ws + 32;
  int sc1 = 0x7F7F7F7F; asm volatile("" : "+v"(sc1));
  int sc8 = 0x72727272; asm volatile("" : "+v"(sc8));
  float m_reg = 0.f; f32x16 o[5] = {}; f32x16 negm;
#pragma unroll
  for (int r = 0; r < 16; ++r) negm[r] = P8_ONE;
  v8i q8;
  { const unsigned char* qp = QK8 + (size_t)(qrow0 + wq * QBLK + r32) * 1024 + h * 128 + map * 64 + hi * 32;
    const v4i a = *(const v4i*)qp, b = *(const v4i*)(qp + 16); q8 = __builtin_shufflevector(a, b, 0, 1, 2, 3, 4, 5, 6, 7); }
  const unsigned char* Kg = QK8 + K8T_OFF + (size_t)bh * (LT / 64) * 8192;
  const unsigned char* Vg = VT8 + (size_t)bh * (LT / 64) * 8192;
  const unsigned kgo = (unsigned)((tid >> 3) * 128 + (((tid & 7) ^ ((tid >> 4) & 7)) << 4)), vgo = (unsigned)((tid >> 2) * 64 + (((tid & 3) ^ ((tid >> 4) & 3)) << 4));
  const int wdst = __builtin_amdgcn_readfirstlane(wid) * 1024;
#define SDMA8(t, bb) do { const int b_ = (bb); \
    const unsigned char* kt_ = Kg + (size_t)(unsigned)(t) * 8192; const unsigned char* vt_ = Vg + (size_t)(unsigned)(t) * 8192; asm volatile("" : "+s"(kt_), "+s"(vt_));     \
    __builtin_amdgcn_global_load_lds((const unsigned*)(kt_ + kgo), (LAS unsigned*)(LAS char*)(K_lds + b_ * K8B + wdst), 16, 0, 0); \
    __builtin_amdgcn_global_load_lds((const unsigned*)(vt_ + vgo), (LAS unsigned*)(LAS char*)(V_lds + b_ * V8B + wdst), 16, 0, 0); } while (0)
#define TBAR8(n) do { asm volatile("s_waitcnt vmcnt(%0)\n\ts_waitcnt lgkmcnt(0)" :: "n"(n) : "memory"); __builtin_amdgcn_s_barrier(); asm volatile("" ::: "memory"); } while (0)
#define RESC8(a) do { if (__any((a) < 1.f)) { if (hi == 0) al_l[r32] = (a); asm volatile("s_nop 15\n\ts_nop 15\n\ts_waitcnt lgkmcnt(0)" ::: "memory"); \
    _Pragma("unroll") for (int d = 0; d < 5; ++d) _Pragma("unroll") for (int r = 0; r < 16; ++r) o[d][r] *= al_l[crow(r, hi)]; } } while (0)
  f32x16 pA0, pA1, pB0, pB1; float alA, alB; v8i pa; const int NT = seq / KVBLK;
#define KBUF8(b) (K_lds + (b) * K8B)
#define VBUF8(b) (V_lds + (b) * V8B)
  const int o8_ = opaque_int(0x38383838);
  for (int i = tid; i < NB8 * 128; i += 512) *(v4i*)(V_lds + (i >> 7) * V8B + 8192 + (i & 127) * 16) = (v4i){o8_, o8_, o8_, o8_};
#pragma unroll
  for (int t = 0; t <= DIST8; ++t) SDMA8(t < NT ? t : NT - 1, t);
  TBAR8(2 * DIST8);
  qkt8(pA0, pA1, KBUF8(0), q8, r32, hi, map, negm, sc1, sc8); partialSM8(pA0, pA1, m_reg, negm, alA);
  TBAR8(2 * (DIST8 - 2));
  const int kof0 = r32 * 128 + (((4 * map + 2 * hi) ^ ((r32 >> 1) & 7)) << 4), kof1 = r32 * 128 + (((4 * map + 2 * hi + 1) ^ ((r32 >> 1) & 7)) << 4);
  const int vof0 = r32 * 64 + (((2 * hi) ^ ((r32 >> 2) & 3)) << 4), vof1 = r32 * 64 + (((2 * hi + 1) ^ ((r32 >> 2) & 3)) << 4);
#define VF8(Vb_, f_) ldsrd32((Vb_) + vof0 + (f_) * 2048, (Vb_) + vof1 + (f_) * 2048)
#define KF8(Kb_, f_) ldsrd32((Kb_) + kof0 + (f_) * 4096, (Kb_) + kof1 + (f_) * 4096)
  int b2 = NB8 - 1, b1 = 0, b0 = 1, bn = 2;
  v8i kf0 = KF8(KBUF8(1), 0), kf1 = KF8(KBUF8(1), 1);
#define HSTEP8(jt, pX0, pX1, alX, pY0, pY1) do { \
    const char* Vb_ = VBUF8(b1); float mx_; \
    SBAR(); \
    MFMA8_NEW(pX0, kf0, q8, negm, sc1, sc8); \
    SBAR(); \
    v8i va_ = VF8(Vb_, 0), vb_ = VF8(Vb_, 1); const v8i vc_ = VF8(Vb_, 2); \
    _Pragma("unroll") for (int g = 0; g < 4; ++g) pa[g] = (int)pk4_u8(pY0[4 * g], pY0[4 * g + 1], pY0[4 * g + 2], pY0[4 * g + 3]); \
    SBAR(); \
    MFMA8_NEW(pX1, kf1, q8, negm, sc1, sc8); \
    SBAR(); \
    _Pragma("unroll") for (int g = 0; g < 4; ++g) pa[4 + g] = (int)pk4_u8(pY1[4 * g], pY1[4 * g + 1], pY1[4 * g + 2], pY1[4 * g + 3]); \
    { const int tn_ = (jt) + DIST8 < NT ? (jt) + DIST8 : NT - 1; SDMA8(tn_, b2); }     \
    SBAR(); \
    asm volatile("s_nop 4" ::: "memory"); \
    MFMA8_ACC(o[0], pa, va_, sc1); va_ = VF8(Vb_, 3); SBAR(); \
    MFMA8_ACC(o[1], pa, vb_, sc1); vb_ = VF8(Vb_, 4); kf0 = KF8(KBUF8(bn), 0); kf1 = KF8(KBUF8(bn), 1); mx_ = max16(pX0, pX0[0]); SBAR(); \
    MFMA8_ACC(o[2], pa, vc_, sc1); mx_ = max16(pX1, mx_); SBAR(); \
    MFMA8_ACC(o[3], pa, va_, sc1); \
    MFMA8_ACC(o[4], pa, vb_, sc1); \
    if (__builtin_expect(!__all(mx_ <= P8_ONE + THR8), 0)) { decideSM8(mx_, pX0, pX1, negm, alX); RESC8(alX); }     \
    TBAR8(2 * (DIST8 - 2)); b2 = b1; b1 = b0; b0 = bn; bn = (bn + 1 == NB8) ? 0 : bn + 1; } while (0)
  for (int j = 1; j + 1 < NT; j += 2) {
    HSTEP8(j, pB0, pB1, alB, pA0, pA1);
    HSTEP8(j + 1, pA0, pA1, alA, pB0, pB1);
  }
  SBAR(); MFMA8_NEW(pB0, kf0, q8, negm, sc1, sc8); MFMA8_NEW(pB1, kf1, q8, negm, sc1, sc8); SBAR();
  finishSM8(pA0, pA1, pa); SBAR();
  pv8(o, VBUF8(b1), pa, r32, hi, sc1); partialSM8(pB0, pB1, m_reg, negm, alB);
  RESC8(alB);
  finishSM8(pB0, pB1, pa); SBAR();
  pv8(o, VBUF8(b0), pa, r32, hi, sc1);
  asm volatile("s_nop 15\n\ts_nop 15" : "+v"(o[0]), "+v"(o[1]), "+v"(o[2]), "+v"(o[3]), "+v"(o[4]));
#undef HSTEP8
#undef VF8
#undef KF8
#undef KBUF8
#undef VBUF8
#undef SDMA8
#undef TBAR8
  { const int tid_e = opaque_tid(wave0), lane_e = tid_e & 63; const int lane = lane_e, r32 = lane_e & 31, hi = lane_e >> 5, wid = tid_e >> 6, map = wid >> 2, wq = wid & 3; (void)map; (void)wq;
  float rli[16];
#pragma unroll
  for (int r = 0; r < 16; ++r) rli[r] = __builtin_amdgcn_rcpf(o[4][r]);
  asm volatile("s_waitcnt vmcnt(0)" ::: "memory");
  __syncthreads();
  float* stash = (float*)lds + wq * 4096;
  if (map == 1) {
#pragma unroll
    for (int d0 = 0; d0 < 4; ++d0)
#pragma unroll
      for (int r = 0; r < 16; ++r) stash[(d0 * 16 + r) * 64 + lane] = lam * o[d0][r] * rli[r];
  }
  __syncthreads();
  if (map == 0) {
    float rs[16];
#pragma unroll
    for (int r = 0; r < 16; ++r) {
      float ss = 0.f;
#pragma unroll
      for (int d0 = 0; d0 < 4; ++d0) { const float a = o[d0][r] * rli[r] - stash[(d0 * 16 + r) * 64 + lane]; o[d0][r] = a; ss += a * a; }
      rs[r] = ss;
    }
#pragma unroll
    for (int st = 1; st < 32; st <<= 1)
#pragma unroll
      for (int r = 0; r < 16; ++r) rs[r] += shfl_xor_l(rs[r], lane, st);
#pragma unroll
    for (int r = 0; r < 16; ++r) rs[r] = oscale * __builtin_amdgcn_rsqf(rs[r] * (1.0f / 128.0f) + EPS);
    float nwv[4];
#pragma unroll
    for (int d0 = 0; d0 < 4; ++d0) nwv[d0] = nw[d0 * 32 + r32];
    bf16_t* Ow = MIX + (size_t)(qrow0 + wq * QBLK) * D + h * 128;
#pragma unroll
    for (int r = 0; r < 16; ++r) { const int orow = crow(r, hi);
#pragma unroll
      for (int d0 = 0; d0 < 4; ++d0) Ow[(size_t)orow * D + d0 * 32 + r32] = f2bf(o[d0][r] * rs[r] * nwv[d0]); }
  }
  }
  __syncthreads();
#undef RESC8
}
}

struct Params {
    const float *x, *c, *ctx, *c_ctx, *w_in, *w_out, *ada_w, *ada_b, *norm1_w, *norm2_w, *diff_lambda, *diff_norm_w, *pool_w, *pool_scale,
                *ret_a_f, *ret_a_b, *ret_norm_w, *router_w, *router_b, *moe_g, *moe_u, *moe_d, *final_norm_w;
    float* out; unsigned char* ws;
};

__device__ __forceinline__ int rowmap(int kind, int n) {
    if (kind == 0) {
        const bool rope = (n < 1024) || (n >= OFF_RQ && n < OFF_RV);
        if (rope) { const int d = n & 63; return (n & ~63) + ((d >> 5) << 5) + ((d & 15) << 1) + ((d >> 4) & 1); }
        return n;
    } else if (kind == 1) return n;
    else {
        const int a = n >> 2, j = n & 3, bj = a & 1, t = a >> 1, fq = t & 3, wc = (t >> 2) & 3, pn = t >> 4;
        return pn * 256 + bj * 128 + wc * 32 + 8 * fq + j + (kind == 3 ? 4 : 0);
    }
}
__device__ __forceinline__ void transpose_item(const float* W, int K, int N, bf16_t* WT, int kind, float* scr, int item, int lane) {
    const int nblk = N / 32, kb = item / nblk, nb = item % nblk, k0 = 64 * kb, n0 = 32 * nb;
    float tv[32];
#pragma unroll
    for (int i = 0; i < 32; ++i) tv[i] = W[(size_t)(k0 + 2 * i + (lane >> 5)) * N + n0 + (lane & 31)];
#pragma unroll
    for (int i = 0; i < 32; ++i) scr[(2 * i + (lane >> 5)) * 33 + (lane & 31)] = tv[i];
    asm volatile("s_waitcnt lgkmcnt(0)" ::: "memory");
    const int c = lane & 7;
#pragma unroll
    for (int j = 0; j < 4; ++j) { const int n = (lane >> 3) + 8 * j; const float* s = scr + (8 * c) * 33 + n;
        u32x4 o; o.x = cvt_pk_bf16(s[0 * 33], s[1 * 33]); o.y = cvt_pk_bf16(s[2 * 33], s[3 * 33]); o.z = cvt_pk_bf16(s[4 * 33], s[5 * 33]); o.w = cvt_pk_bf16(s[6 * 33], s[7 * 33]);
        *(u32x4*)(WT + (size_t)rowmap(kind, n0 + n) * K + k0 + 8 * c) = o; }
    asm volatile("s_waitcnt lgkmcnt(0)" ::: "memory");
}

__device__ __forceinline__ const void* ldp(volatile LAS unsigned* tab, int k) {
    const unsigned lo = tab[2 * k], hi = tab[2 * k + 1];
    const unsigned long long v = ((unsigned long long)(unsigned)__builtin_amdgcn_readfirstlane(hi) << 32) | (unsigned long long)(unsigned)__builtin_amdgcn_readfirstlane(lo);
    const GAS char* g = (const GAS char*)v;
    return (const void*)g;
}
enum { I_X = 0, I_C, I_CTX, I_CCTX, I_WIN, I_WOUT, I_ADAW, I_ADAB, I_N1W, I_N2W, I_DLAM, I_DNW, I_POOLW, I_POOLS, I_RAF, I_RAB, I_RNW, I_RW, I_RB, I_MG, I_MU, I_MD, I_FNW, I_OUT, I_WS };
__device__ __forceinline__ void transpose_item_fp8(const float* W, int K, int N, unsigned char* WT, int kind, float* scr, int item, int lane) {
    const int nblk = N / 32, kb = item / nblk, nb = item % nblk, k0 = 64 * kb, n0 = 32 * nb;
    float tv[32];
#pragma unroll
    for (int i = 0; i < 32; ++i) tv[i] = W[(size_t)(k0 + 2 * i + (lane >> 5)) * N + n0 + (lane & 31)];
#pragma unroll
    for (int i = 0; i < 32; ++i) scr[(2 * i + (lane >> 5)) * 33 + (lane & 31)] = tv[i];
    asm volatile("s_waitcnt lgkmcnt(0)" ::: "memory");
    const int c = lane & 7;
#pragma unroll
    for (int j = 0; j < 4; ++j) { const int n = (lane >> 3) + 8 * j; const float* sp = scr + (8 * c) * 33 + n;
        u32x2 o; o.x = pk4_fp8(sp[0 * 33] * pg8::WSCALE, sp[1 * 33] * pg8::WSCALE, sp[2 * 33] * pg8::WSCALE, sp[3 * 33] * pg8::WSCALE);
        o.y = pk4_fp8(sp[4 * 33] * pg8::WSCALE, sp[5 * 33] * pg8::WSCALE, sp[6 * 33] * pg8::WSCALE, sp[7 * 33] * pg8::WSCALE);
        *(u32x2*)(WT + (size_t)rowmap(kind, n0 + n) * K + k0 + 8 * c) = o; }
    asm volatile("s_waitcnt lgkmcnt(0)" ::: "memory");
}
#ifndef PHMASK
#define PHMASK 0xFFFF
#endif
#define PH(k) if (PHMASK & (1 << (k)))
#ifndef DUPMASK
#define DUPMASK 0
#endif
#define REP(k) for (int rep_ = 0, nrep_ = opaque_int(((DUPMASK >> (k)) & 1) + 1); rep_ < nrep_; ++rep_)
__global__ void __launch_bounds__(512, 2) fwd_kernel(Params p) {
    extern __shared__ __attribute__((aligned(16))) unsigned char lds_all[];
    const int tid = threadIdx.x;
    const int wave0 = __builtin_amdgcn_readfirstlane(tid >> 6);
    const int G0 = gridDim.x; const int bx0 = blockIdx.x;
    const int vcu0 = (G0 % 8 == 0) ? (bx0 % 8) * (G0 / 8) + bx0 / 8 : bx0;
    LAS unsigned char* ldsc = (LAS unsigned char*)lds_all;
    volatile LAS unsigned* LP = (volatile LAS unsigned*)(ldsc + LC_PTR);
#define INP(k) ((const float*)ldp(LP, (k)))
#define WSP() ((unsigned char*)ldp(LP, I_WS))
#define OUTP() ((float*)ldp(LP, I_OUT))
    for (int u = tid; u < LDSCTL_BYTES / 4; u += 512) ((LAS unsigned*)ldsc)[u] = 0u;
    __syncthreads();
    if (tid == 0) {
        volatile LAS unsigned long long* T = (volatile LAS unsigned long long*)(ldsc + LC_PTR);
        T[I_X] = (unsigned long long)p.x; T[I_C] = (unsigned long long)p.c; T[I_CTX] = (unsigned long long)p.ctx; T[I_CCTX] = (unsigned long long)p.c_ctx;
        T[I_WIN] = (unsigned long long)p.w_in; T[I_WOUT] = (unsigned long long)p.w_out; T[I_ADAW] = (unsigned long long)p.ada_w; T[I_ADAB] = (unsigned long long)p.ada_b;
        T[I_N1W] = (unsigned long long)p.norm1_w; T[I_N2W] = (unsigned long long)p.norm2_w; T[I_DLAM] = (unsigned long long)p.diff_lambda; T[I_DNW] = (unsigned long long)p.diff_norm_w;
        T[I_POOLW] = (unsigned long long)p.pool_w; T[I_POOLS] = (unsigned long long)p.pool_scale; T[I_RAF] = (unsigned long long)p.ret_a_f; T[I_RAB] = (unsigned long long)p.ret_a_b;
        T[I_RNW] = (unsigned long long)p.ret_norm_w; T[I_RW] = (unsigned long long)p.router_w; T[I_RB] = (unsigned long long)p.router_b; T[I_MG] = (unsigned long long)p.moe_g;
        T[I_MU] = (unsigned long long)p.moe_u; T[I_MD] = (unsigned long long)p.moe_d; T[I_FNW] = (unsigned long long)p.final_norm_w; T[I_OUT] = (unsigned long long)p.out; T[I_WS] = (unsigned long long)p.ws;
    }
    __syncthreads();
    XcdBarrier bar = xcd_barrier_post((unsigned*)(WSP() + WS_CTL) + CW_BAR, (volatile LAS unsigned*)(ldsc + LC_BARW));
#define GRID_BAR() xcd_barrier(bar)
#define WSPTRS() const int tid = opaque_tid(wave0), lane = tid & 63, wave = __builtin_amdgcn_readfirstlane(tid >> 6); const int G = opaque_int(G0), bx = opaque_int(bx0), vcu = opaque_int(vcu0), NGW = G * 8; const int gw = vcu * 8 + wave; \
    unsigned char* const lds = lds_all + opaque_int(RING_OFF); LAS unsigned char* ldsl = (LAS unsigned char*)lds; (void)lane; (void)gw; (void)bx; (void)NGW; (void)ldsl; unsigned char* ws = WSP(); unsigned* ctl = (unsigned*)(ws + WS_CTL); float* MODV = (float*)(ws + WS_MOD); float* ROPEC = (float*)(ws + WS_ROPE); float* ROPES = ROPEC + 1024; \
    bf16_t* POOLWT = (bf16_t*)(ws + WS_POOLW); float* GATE = (float*)(ws + WS_GATE); int* TOK = (int*)(ws + WS_TOK); float* XC = (float*)(ws + WS_XC); float* KV = (float*)(ws + WS_KV); \
    bf16_t* ST = (bf16_t*)(ws + WS_ST); bf16_t* WIN = (bf16_t*)(ws + WS_WIN); bf16_t* WOUT = (bf16_t*)(ws + WS_WOUT); unsigned char* WGU = ws + WS_WGU; unsigned char* WDN = ws + WS_WDN; unsigned char* H8 = ws + WS_H8; unsigned char* QK8 = ws + WS_QK8; unsigned char* VT8 = ws + WS_VT8; (void)QK8; (void)VT8; \
    bf16_t* H = (bf16_t*)(ws + WS_H); bf16_t* XB = (bf16_t*)(ws + WS_XB); (void)XB; bf16_t* P = (bf16_t*)(ws + WS_P); bf16_t* MIX = (bf16_t*)(ws + WS_MIX); unsigned char* ACT = ws + WS_ACT; unsigned char* Y2 = ws + WS_Y2; float* OUT = OUTP(); \
    (void)ctl; (void)MODV; (void)ROPEC; (void)ROPES; (void)POOLWT; (void)GATE; (void)TOK; (void)XC; (void)KV; (void)ST; (void)WIN; (void)WOUT; (void)WGU; (void)WDN; (void)H8; (void)H; (void)P; (void)MIX; (void)ACT; (void)Y2; (void)OUT

    PH(0) REP(0) { WSPTRS();
        float* scr = (float*)(lds + wave * 8448);
        for (int mb = vcu; mb < 192 + 17; mb += G) {
        if (mb < 192) {
            float* sil = (float*)(lds + 72 * 1024);
            float* part = (float*)(lds + 108 * 1024);
            for (int i = tid; i < 9 * 1024; i += 512) { const int r = i >> 10, k = i & 1023; const float cv = (r < 8) ? INP(I_C)[r * 1024 + k] : INP(I_CCTX)[k]; sil[i] = cv / (1.0f + expf(-cv)); }
            __syncthreads();
            const int l = mb / 48, n0 = (mb - l * 48) * 128, cl = (wave & 1) * 64 + lane, kq = wave >> 1;
            const float* wp = INP(I_ADAW) + (size_t)l * 1024 * 6144 + (size_t)(kq * 256) * 6144 + n0 + cl;
            float a[9];
#pragma unroll
            for (int r = 0; r < 9; ++r) a[r] = 0.f;
            for (int k = 0; k < 256; k += 16) {
                float wv[16];
#pragma unroll
                for (int q = 0; q < 16; ++q) wv[q] = wp[(size_t)(k + q) * 6144];
#pragma unroll
                for (int q4 = 0; q4 < 4; ++q4)
#pragma unroll
                    for (int r = 0; r < 9; ++r) { const f32x4 s4 = *(const f32x4*)(sil + r * 1024 + kq * 256 + k + 4 * q4);
                        a[r] += (s4[0] * wv[4 * q4] + s4[1] * wv[4 * q4 + 1]) + (s4[2] * wv[4 * q4 + 2] + s4[3] * wv[4 * q4 + 3]); }
            }
#pragma unroll
            for (int r = 0; r < 9; ++r) part[(kq * 9 + r) * 128 + cl] = a[r];
            __syncthreads();
            for (int i = tid; i < 9 * 128; i += 512) { const int r = i >> 7, c = i & 127;
                MODV[((size_t)l * 9 + r) * 6144 + n0 + c] = INP(I_ADAB)[l * 6144 + n0 + c] + ((part[(0 * 9 + r) * 128 + c] + part[(1 * 9 + r) * 128 + c]) + (part[(2 * 9 + r) * 128 + c] + part[(3 * 9 + r) * 128 + c])); }
            __syncthreads();
        }
        if (mb == 192) {
            for (int i = tid; i < 1024; i += 512) { const int pos = i >> 4, f = i & 15; const double inv = pow(10000.0, -(double)f / 16.0); const double ang = (double)pos * inv; ROPEC[i] = (float)cos(ang); ROPES[i] = (float)sin(ang); }
        }
        if (mb >= 193) {
            const int lg = mb - 193;
            for (int i = tid; i < 4096; i += 512) { const int j = i >> 6, c = i & 63; POOLWT[(size_t)lg * 4096 + i] = f2bf(INP(I_POOLW)[(size_t)lg * 4096 + c * 64 + j]); }
        }
        }
        constexpr int I_IN = 16 * 44, I_OUT = 16 * 16, I_L = I_IN + I_OUT, I_E = 192, I_DENSE = 4 * I_L, NITEMS = I_DENSE + 64 * 3 * I_E;
        for (int it = gw; it < NITEMS; it += NGW) {
            const float* W_; unsigned char* dst_; int N_, K_, kind_, fp8_, item_;
            if (it < I_DENSE) { const int l_ = it / I_L, r_ = it - l_ * I_L;
                if (r_ < I_IN) { W_ = INP(I_WIN) + (size_t)l_ * 1024 * INW; K_ = 1024; N_ = INW; dst_ = (unsigned char*)WIN + (size_t)l_ * INW * 1024; kind_ = 0; fp8_ = 1; item_ = r_; }
                else { W_ = INP(I_WOUT) + (size_t)l_ * 1024 * 1024; K_ = 1024; N_ = 1024; dst_ = (unsigned char*)(WOUT + (size_t)l_ * 1024 * 1024); kind_ = 1; fp8_ = 0; item_ = r_ - I_IN; }
            } else { const int j_ = it - I_DENSE, le_ = j_ / (3 * I_E), r_ = j_ - le_ * 3 * I_E, which_ = r_ / I_E; item_ = r_ - which_ * I_E; fp8_ = 1;
                if (which_ == 0) { W_ = INP(I_MG) + (size_t)le_ * 1024 * DE; K_ = 1024; N_ = DE; dst_ = WGU + (size_t)le_ * NGU * 1024; kind_ = 2; }
                else if (which_ == 1) { W_ = INP(I_MU) + (size_t)le_ * 1024 * DE; K_ = 1024; N_ = DE; dst_ = WGU + (size_t)le_ * NGU * 1024; kind_ = 3; }
                else { W_ = INP(I_MD) + (size_t)le_ * DE * 1024; K_ = DE; N_ = 1024; dst_ = WDN + (size_t)le_ * 1024 * DE; kind_ = 1; } }
            const int nblk_ = N_ / 64, kb_ = item_ / nblk_, nb_ = item_ - kb_ * nblk_, k0_ = 64 * kb_, n_ = 64 * nb_ + lane;
            float tv[64];
            { const float* p_ = W_ + (size_t)k0_ * N_ + n_; const size_t st_ = (size_t)N_;
#pragma unroll
              for (int i = 0; i < 64; ++i) { tv[i] = *p_; p_ += st_; asm volatile("" : "+v"(p_)); } }
            const size_t drow = (size_t)rowmap(kind_, n_) * K_ + k0_;
            if (fp8_) {
#pragma unroll
                for (int j = 0; j < 4; ++j) { u32x4 o;
#pragma unroll
                    for (int q = 0; q < 4; ++q) o[q] = pk4_fp8(tv[16 * j + 4 * q] * pg8::WSCALE, tv[16 * j + 4 * q + 1] * pg8::WSCALE, tv[16 * j + 4 * q + 2] * pg8::WSCALE, tv[16 * j + 4 * q + 3] * pg8::WSCALE);
                    *(u32x4*)(dst_ + drow + 16 * j) = o; }
            } else {
#pragma unroll
                for (int j = 0; j < 8; ++j) { u32x4 o;
#pragma unroll
                    for (int q = 0; q < 4; ++q) o[q] = cvt_pk_bf16(tv[8 * j + 2 * q], tv[8 * j + 2 * q + 1]);
                    *(u32x4*)((bf16_t*)dst_ + drow + 8 * j) = o; }
            }
        }
    }
    GRID_BAR();

    for (int l = 0; l < DEPTH; ++l) {
        const bool last = (l == DEPTH - 1);
        const float lam_init = 0.8f - 0.6f * expf(-0.3f * (float)l);
        PH(1) REP(1) { WSPTRS(); const float* modl = MODV + (size_t)l * 9 * 6144;
            const float* nw = INP(I_N1W) + l * D;
            const float* xin = INP(I_X); const float* cin = INP(I_CTX);
            const int CH = (M + NGW - 1) / NGW;
            const int r0 = gw * CH, r1 = (r0 + CH < M) ? r0 + CH : M;
            int curvar = -1;
            f32x4 wsc[4] = {}, shv[4] = {}, g2v[4] = {};
            f32x4 xv[4] = {}; unsigned ya[4] = {}, yb[4] = {};
#define N1_SRC(row_, ptr_) do { const int b_ = (row_) / LT, j_ = (row_) - b_ * LT; const bool c_ = j_ < LC; const size_t xo_ = c_ ? ((size_t)(b_ * LC + j_)) * D : ((size_t)(b_ * L + j_ - LC)) * D; \
        ptr_ = (c_ ? cin : xin) + xo_; } while (0)
#define N1_LOAD(row_, X_, A_, B_) do { if (l == 0) { const float* sp_; N1_SRC(row_, sp_); _Pragma("unroll") for (int jj = 0; jj < 4; ++jj) X_[jj] = *(const f32x4*)(sp_ + 4 * lane + 256 * jj); } \
        else { _Pragma("unroll") for (int jj = 0; jj < 4; ++jj) X_[jj] = bf4_to_f4(*(const u32x2*)(XB + (size_t)(row_) * D + 4 * lane + 256 * jj)); } \
        if (l > 0) { const unsigned char* y0_ = Y2 + (size_t)(2 * (row_)) * D; _Pragma("unroll") for (int jj = 0; jj < 4; ++jj) { A_[jj] = *(const unsigned*)(y0_ + 4 * lane + 256 * jj); B_[jj] = *(const unsigned*)(y0_ + D + 4 * lane + 256 * jj); } } } while (0)
            if (r0 < r1) N1_LOAD(r0, xv, ya, yb);
            for (int row = r0; row < r1; ++row) {
                f32x4 xn[4] = {}; unsigned yan[4] = {}, ybn[4] = {};
                if (row + 1 < r1) N1_LOAD(row + 1, xn, yan, ybn);
                const int b = row / LT, j = row - b * LT; const bool isctx = j < LC; const int var = isctx ? 8 : b;
                if (var != curvar) {
                    curvar = var;
                    const float* mod = modl + (size_t)var * 6144;
                    const float* g2 = MODV + ((size_t)(l > 0 ? l - 1 : 0) * 9 + var) * 6144 + 5 * 1024;
#pragma unroll
                    for (int jj = 0; jj < 4; ++jj) { const int cc = 4 * lane + 256 * jj; wsc[jj] = *(const f32x4*)(nw + cc) * (*(const f32x4*)(mod + 1024 + cc) + 1.0f); shv[jj] = *(const f32x4*)(mod + cc); g2v[jj] = *(const f32x4*)(g2 + cc) * pg8::YINV; }
                }
                if (l > 0) {
#pragma unroll
                    for (int jj = 0; jj < 4; ++jj) { xv[jj] = xv[jj] + g2v[jj] * (fp8x4_to_f4(ya[jj]) + fp8x4_to_f4(yb[jj]));
                        u32x2 w; w.x = cvt_pk_bf16(xv[jj][0], xv[jj][1]); w.y = cvt_pk_bf16(xv[jj][2], xv[jj][3]); *(u32x2*)(XB + (size_t)row * D + 4 * lane + 256 * jj) = w; xv[jj] = bf4_to_f4(w); }
                }
                float ss = 0.f;
#pragma unroll
                for (int jj = 0; jj < 4; ++jj) ss += (xv[jj][0] * xv[jj][0] + xv[jj][1] * xv[jj][1]) + (xv[jj][2] * xv[jj][2] + xv[jj][3] * xv[jj][3]);
                ss = wave_sum(ss, lane);
                const float rstd = __builtin_amdgcn_rsqf(ss * (1.0f / D) + EPS);
#pragma unroll
                for (int jj = 0; jj < 4; ++jj) {
                    const f32x4 hv = xv[jj] * rstd * wsc[jj] + shv[jj];
                    *(unsigned*)((unsigned char*)H + (size_t)row * D + 4 * lane + 256 * jj) = pk4_fp8(hv[0], hv[1], hv[2], hv[3]);
                }
#pragma unroll
                for (int jj = 0; jj < 4; ++jj) { xv[jj] = xn[jj]; ya[jj] = yan[jj]; yb[jj] = ybn[jj]; }
            }
#undef N1_SRC
#undef N1_LOAD
        }
        GRID_BAR();
        PH(2) REP(2) { WSPTRS();
            pg8::DenseSched S; S.init(M, INW, D, G, bx, (unsigned char*)WIN + (size_t)l * INW * 1024, false, 1);
            pg8::EpiG1 E{P, ROPEC, ROPES, QK8};
            pg8::gemm_phase<pg8::EpiG1, pg8::DenseSched, true>(ldsl, (const char*)H, D, S, E, wave0);
        }
        GRID_BAR();
        PH(3) REP(3) { WSPTRS();
            {
                using namespace att;
                char* Vi = (char*)lds; char* Kf = (char*)lds + 16384; char* Kb = (char*)lds + 32768;
                const int dir = wave >> 2, eb = (wave >> 1) & 1, db = wave & 1, r32 = lane & 31, hi = lane >> 5;
                for (int it = vcu; it < NB * NCH * 4; it += G) {
                    const int h = it & 3, bc = it >> 2, b = bc / NCH, ch = bc - b * NCH;
                    const int rowbase = b * LT + ch * 128;
                    const float lgf2 = -expf(INP(I_RAF)[l * 4 + h]) * LOG2E, lgb2 = -expf(INP(I_RAB)[l * 4 + h]) * LOG2E;
#pragma unroll
                    for (int i = 0; i < 2; ++i) { const int chunk = tid + 512 * i, c = chunk >> 3, c8 = (chunk & 7) * 8;
                        const int off = (c >> 6) * 8192 + v_st<2>(c & 63, c8);
                        *(bf16x8*)(Vi + off) = *(const bf16x8*)(P + (size_t)(rowbase + c) * INW + OFF_RV + h * 64 + c8);
                        const bf16x8 kk = *(const bf16x8*)(P + (size_t)(rowbase + c) * INW + OFF_RK + h * 64 + c8);
                        const float zf = __builtin_amdgcn_exp2f(lgf2 * (float)(127 - c)), zb = __builtin_amdgcn_exp2f(lgb2 * (float)c);
                        u32x4 wf, wb;
#pragma unroll
                        for (int z = 0; z < 4; ++z) { const float a0 = bf2f((bf16_t)kk[2 * z]), a1 = bf2f((bf16_t)kk[2 * z + 1]); wf[z] = cvt_pk_bf16(a0 * zf, a1 * zf); wb[z] = cvt_pk_bf16(a0 * zb, a1 * zb); }
                        *(u32x4*)(Kf + off) = wf; *(u32x4*)(Kb + off) = wb; }
                    __syncthreads();
                    f32x16 acc = {};
                    const int vbase = (int)(uintptr_t)Vi + v_rd_base(lane) + eb * 512;
                    const int kbase = (int)(uintptr_t)(dir ? Kb : Kf) + v_rd_base(lane) + db * 512;
#pragma unroll
                    for (int tt = 0; tt < 2; ++tt)
#pragma unroll
                        for (int ks = 0; ks < 4; ++ks) {
                            s16x4 al, ah, bl, bh;
                            asm volatile("ds_read_b64_tr_b16 %0, %1 offset:%2" : "=&v"(al) : "v"(vbase), "i"(tt * 8192 + ks * 2048) : "memory");
                            asm volatile("ds_read_b64_tr_b16 %0, %1 offset:%2" : "=&v"(ah) : "v"(vbase), "i"(tt * 8192 + ks * 2048 + 1024) : "memory");
                            asm volatile("ds_read_b64_tr_b16 %0, %1 offset:%2" : "=&v"(bl) : "v"(kbase), "i"(tt * 8192 + ks * 2048) : "memory");
                            asm volatile("ds_read_b64_tr_b16 %0, %1 offset:%2" : "=&v"(bh) : "v"(kbase), "i"(tt * 8192 + ks * 2048 + 1024) : "memory");
                            asm volatile("s_waitcnt lgkmcnt(0)" ::: "memory"); SBAR();
                            const bf16x8 av = (bf16x8){al[0], al[1], al[2], al[3], ah[0], ah[1], ah[2], ah[3]}, bv = (bf16x8){bl[0], bl[1], bl[2], bl[3], bh[0], bh[1], bh[2], bh[3]};
                            acc = __builtin_amdgcn_mfma_f32_32x32x16_bf16(av, bv, acc, 0, 0, 0);
                        }
                    float* op = KV + ((size_t)(((b * 4 + h) * 2 + dir) * NCH + ch)) * 4096 + (size_t)(eb * 32) * 64 + db * 32 + r32;
#pragma unroll
                    for (int r = 0; r < 16; ++r) op[crow(r, hi) * 64] = acc[r];
                    __syncthreads();
                }
            }
            {
                bf16_t* Vt = (bf16_t*)lds;
                for (int it = vcu; it < NB * 4 * (LT / 64); it += G) {
                    const int t = it % (LT / 64), bh = it / (LT / 64), b = bh >> 2, h = bh & 3;
                    const size_t row0 = (size_t)b * LT + (size_t)t * 64;
#pragma unroll
                    for (int i = 0; i < 2; ++i) { const int chunk = tid + 512 * i, key = chunk >> 4, c8 = (chunk & 15) * 8;
                        *(bf16x8*)(Vt + key * 136 + c8) = *(const bf16x8*)(P + (row0 + key) * INW + OFF_DV + h * 128 + c8); }
                    __syncthreads();
                    { const int e = tid >> 2, q = tid & 3, hi2 = q >> 1, sb = 16 * (q & 1);
                      float v[16];
#pragma unroll
                      for (int jx = 0; jx < 16; ++jx) { const int sx = sb + jx; const int key = (sx < 16) ? ((sx & 3) + 8 * (sx >> 2) + 4 * hi2) : (32 + ((sx - 16) & 3) + 8 * ((sx - 16) >> 2) + 4 * hi2); v[jx] = bf2f(Vt[key * 136 + e]); }
                      u32x4 w; w.x = pk4_fp8(v[0], v[1], v[2], v[3]); w.y = pk4_fp8(v[4], v[5], v[6], v[7]); w.z = pk4_fp8(v[8], v[9], v[10], v[11]); w.w = pk4_fp8(v[12], v[13], v[14], v[15]);
                      *(u32x4*)(VT8 + (size_t)it * 8192 + e * 64 + q * 16) = w; }
                    __syncthreads();
                }
            }
        }
        GRID_BAR();
        PH(4) REP(4) { WSPTRS();
            const int nskip = (!last && G > 128) ? 64 : 0;
            if (vcu >= nskip) for (int idx = (vcu - nskip) * 512 + tid; idx < 64 * 4096; idx += (G - nskip) * 512) {
                const int scan = idx >> 12, el = idx & 4095, dir = scan & 1, h = (scan >> 1) & 3;
                const float lg2 = -expf(dir ? INP(I_RAB)[l * 4 + h] : INP(I_RAF)[l * 4 + h]) * LOG2E;
                const float g = __builtin_amdgcn_exp2f(lg2 * 128.0f);
                const float* base = KV + (size_t)scan * NCH * 4096 + el;
                bf16_t* sb = ST + (size_t)scan * NCH * 4096 + el;
                float v[NCH];
#pragma unroll
                for (int ch = 0; ch < NCH; ++ch) v[ch] = base[(size_t)ch * 4096];
                float st = 0.f;
                if (dir == 0) {
#pragma unroll
                    for (int ch = 0; ch < NCH; ++ch) { sb[(size_t)ch * 4096] = f2bf(st); st = g * st + v[ch]; }
                } else {
                    sb[(size_t)1 * 4096] = f2bf(st); st = g * st + v[1];
                    sb[(size_t)0 * 4096] = f2bf(st); st = g * st + v[0];
#pragma unroll
                    for (int ch = NCH - 1; ch >= 2; --ch) { sb[(size_t)ch * 4096] = f2bf(st); st = g * st + v[ch]; }
                }
            }
            const float* dl = INP(I_DLAM) + l * 256;
            const float s1 = wave_sum(dl[lane] * dl[64 + lane], lane), s2 = wave_sum(dl[128 + lane] * dl[192 + lane], lane);
            const float lam = expf(s1) - expf(s2) + lam_init;
            const float* nw = INP(I_DNW) + l * 128;
            const float oscale = 1.0f - lam_init;
            const int nlat = NB * 4 * 32, nunits = nlat + (last ? 0 : 64);
            for (int Lx = vcu; Lx < nunits; Lx += G) {
                int qrow0, krow0, seq, h, bh;
                if (Lx < nlat) { bh = Lx >> 5; const int qb = Lx & 31, b = bh >> 2; h = bh & 3; qrow0 = b * LT + LC + qb * 128; krow0 = b * LT; seq = LT; }
                else { const int c_ = Lx - nlat; bh = c_ >> 1; const int qb = c_ & 1, b = bh >> 2; h = bh & 3; qrow0 = b * LT + qb * 128; krow0 = b * LT; seq = LC; }
                att::attn_unit8(QK8, VT8, qrow0, krow0, seq, bh, h, lam, nw, oscale, MIX, (char*)lds, wave0);
            }
        }
        GRID_BAR();
        PH(5) REP(5) { WSPTRS();
            using namespace att;
            const bool g2c = !last && G == 256;
            const int GW = g2c ? G - 32 : G, nctx = last ? 0 : 32;
            unsigned* ctxcnt = ctl + CW_CTX + 64 * l;
            if (g2c && vcu >= GW) {
                if (rep_ == 0) {
                if (tid == 0) { unsigned sp_ = 0; while (xb_ld(ctxcnt) < 64u) { __builtin_amdgcn_s_sleep(2); if (++sp_ > (1u << 22)) break; }
                    __builtin_amdgcn_fence(__ATOMIC_ACQUIRE, "agent"); asm volatile("s_waitcnt vmcnt(0)" ::: "memory"); }
                __syncthreads();
                const int k = vcu - GW; const float* modl = MODV + (size_t)l * 9 * 6144;
                pg8::OneSched S{(k >> 2) * 17, k & 3, (const char*)(WOUT + (size_t)l * 1024 * 1024), 2 * D};
                pg8::EpiG2 E{INP(I_X), INP(I_CTX), XB, modl, l == 0};
                pg8::gemm_phase<pg8::EpiG2, pg8::OneSched>(ldsl, (const char*)MIX, D, S, E, wave0);
                }
            } else
            for (int pass = (nctx ? 0 : 1); pass < 2; ++pass) {
            const int nret = pass == 0 ? nctx : 512;
            for (int p = pass == 0 ? vcu : (vcu + GW - 64) % GW; p < nret; p += GW) {
                int b, ch, hp;
                if (pass == 0) { b = p >> 2; ch = (p >> 1) & 1; hp = p & 1; } else { b = p >> 6; ch = 2 + ((p >> 1) & 31); hp = p & 1; }
                const int wq = wave & 3, hh = wave >> 2, h = hp * 2 + hh, r32 = lane & 31, hi = lane >> 5;
                const int rowbase = b * LT + ch * 128;
                const float lgf2 = -expf(INP(I_RAF)[l * 4 + h]) * LOG2E, lgb2 = -expf(INP(I_RAB)[l * 4 + h]) * LOG2E;
                char* Hl = (char*)lds + hh * 49152; char* Vl = Hl; char* Kl = Hl + 16384; char* Fl = Hl + 32768; char* Bl = Hl + 40960;
                {
                    const int t4 = tid & 255;
                    const bf16_t* Ft = ST + ((size_t)(((b * 4 + h) * 2 + 0) * NCH + ch)) * 4096;
                    const bf16_t* Bt = ST + ((size_t)(((b * 4 + h) * 2 + 1) * NCH + ch)) * 4096;
                    bf16x8 lv[4], lk[4], lf[2], lb[2];
#pragma unroll
                    for (int i = 0; i < 4; ++i) { const int chunk = t4 + 256 * i, k = chunk >> 3, c8 = (chunk & 7) * 8;
                        lv[i] = *(const bf16x8*)(P + (size_t)(rowbase + k) * INW + OFF_RV + h * 64 + c8);
                        lk[i] = *(const bf16x8*)(P + (size_t)(rowbase + k) * INW + OFF_RK + h * 64 + c8); }
#pragma unroll
                    for (int i = 0; i < 2; ++i) { const int chunk = t4 + 256 * i; lf[i] = *(const bf16x8*)(Ft + chunk * 8); lb[i] = *(const bf16x8*)(Bt + chunk * 8); }
#pragma unroll
                    for (int i = 0; i < 4; ++i) { const int chunk = t4 + 256 * i, k = chunk >> 3, c = chunk & 7;
                        *(bf16x8*)(Vl + (k >> 6) * 8192 + v_st<2>(k & 63, c * 8)) = lv[i];
                        *(bf16x8*)(Kl + k * 128 + ((c ^ (k & 7)) << 4)) = lk[i]; }
#pragma unroll
                    for (int i = 0; i < 2; ++i) { const int chunk = t4 + 256 * i, e = chunk >> 3, c = chunk & 7;
                        *(bf16x8*)(Fl + e * 128 + ((c ^ (e & 7)) << 4)) = lf[i]; *(bf16x8*)(Bl + e * 128 + ((c ^ (e & 7)) << 4)) = lb[i]; }
                }
                const int cq = wq * 32 + r32;
                bf16x8 qr[4];
                const bf16_t* Qw = P + (size_t)(rowbase + cq) * INW + OFF_RQ + h * 64 + hi * 8;
#pragma unroll
                for (int d0 = 0; d0 < 4; ++d0) qr[d0] = ld8(Qw + d0 * 16);
                __syncthreads();
                f32x16 o[2] = {};
                const int vb = (int)(uintptr_t)Vl + v_rd_base(lane);
#pragma unroll 1
                for (int tt = 0; tt < 2; ++tt) {
                    f32x16 p0 = {}, p1 = {};
                    const char* Ka = Kl + (tt * 64 + r32) * 128; const char* Kb2 = Ka + 32 * 128;
#pragma unroll
                    for (int d0 = 0; d0 < 4; ++d0) {
                        const int c = ((2 * d0 + hi) ^ (r32 & 7)) << 4;
                        const bf16x8 k0 = *(const bf16x8*)(Ka + c), k1 = *(const bf16x8*)(Kb2 + c);
                        p0 = __builtin_amdgcn_mfma_f32_32x32x16_bf16(k0, qr[d0], p0, 0, 0, 0);
                        p1 = __builtin_amdgcn_mfma_f32_32x32x16_bf16(k1, qr[d0], p1, 0, 0, 0);
                    }
#pragma unroll
                    for (int r = 0; r < 16; ++r) {
                        const int s0 = tt * 64 + crow(r, hi);
                        const int d0_ = cq - s0, d1_ = cq - (s0 + 32);
                        const float w0 = d0_ >= 0 ? __builtin_amdgcn_exp2f(lgf2 * (float)d0_) : __builtin_amdgcn_exp2f(lgb2 * (float)(-d0_));
                        const float w1 = d1_ >= 0 ? __builtin_amdgcn_exp2f(lgf2 * (float)d1_) : __builtin_amdgcn_exp2f(lgb2 * (float)(-d1_));
                        p0[r] *= w0; p1[r] *= w1;
                    }
                    bf16x8 pa0, pa1, pa2, pa3;
                    PK4(p0, 0, pa0); PK4(p0, 8, pa1); PK4(p1, 0, pa2); PK4(p1, 8, pa3);
                    pv2(o, vb + tt * 8192, pa0, pa1, pa2, pa3);
                }
                {
                    const float xf = __builtin_amdgcn_exp2f(lgf2 * (float)(cq + 1)), xb = __builtin_amdgcn_exp2f(lgb2 * (float)(128 - cq));
#pragma unroll
                    for (int d0 = 0; d0 < 4; ++d0) {
                        u32x4 qf, qb;
#pragma unroll
                        for (int z = 0; z < 4; ++z) { const float a0 = bf2f((bf16_t)qr[d0][2 * z]), a1 = bf2f((bf16_t)qr[d0][2 * z + 1]); qf[z] = cvtpk(a0 * xf, a1 * xf); qb[z] = cvtpk(a0 * xb, a1 * xb); }
                        const bf16x8 qfv = *reinterpret_cast<bf16x8*>(&qf), qbv = *reinterpret_cast<bf16x8*>(&qb);
#pragma unroll
                        for (int eb = 0; eb < 2; ++eb) {
                            const int e = eb * 32 + r32; const int c = ((2 * d0 + hi) ^ (e & 7)) << 4;
                            const bf16x8 f0 = *(const bf16x8*)(Fl + e * 128 + c), b0 = *(const bf16x8*)(Bl + e * 128 + c);
                            o[eb] = __builtin_amdgcn_mfma_f32_32x32x16_bf16(qfv, f0, o[eb], 0, 0, 0);
                            o[eb] = __builtin_amdgcn_mfma_f32_32x32x16_bf16(qbv, b0, o[eb], 0, 0, 0);
                        }
                    }
                }
                {
                    const float w0 = INP(I_RNW)[l * 256 + h * 64 + r32], w1 = INP(I_RNW)[l * 256 + h * 64 + 32 + r32];
                    bf16_t g0[16], g1[16];
#pragma unroll
                    for (int r = 0; r < 16; ++r) { const size_t row = (size_t)(rowbase + wq * 32 + crow(r, hi)); g0[r] = P[row * INW + OFF_RG + h * 64 + r32]; g1[r] = P[row * INW + OFF_RG + h * 64 + 32 + r32]; }
                    float ssv[16];
#pragma unroll
                    for (int r = 0; r < 16; ++r) ssv[r] = o[0][r] * o[0][r] + o[1][r] * o[1][r];
#pragma unroll
                    for (int st = 1; st < 32; st <<= 1)
#pragma unroll
                        for (int r = 0; r < 16; ++r) ssv[r] += shfl_xor_l(ssv[r], lane, st);
#pragma unroll
                    for (int r = 0; r < 16; ++r) {
                        const float rs = __builtin_amdgcn_rsqf(ssv[r] * (1.0f / 64.0f) + EPS);
                        const size_t row = (size_t)(rowbase + wq * 32 + crow(r, hi));
                        MIX[row * D + 768 + h * 64 + r32] = f2bf(silu_f(bf2f(g0[r])) * (o[0][r] * rs * w0));
                        MIX[row * D + 768 + h * 64 + 32 + r32] = f2bf(silu_f(bf2f(g1[r])) * (o[1][r] * rs * w1));
                    }
                }
                if (g2c && pass == 0 && rep_ == 0) { asm volatile("s_waitcnt vmcnt(0)" ::: "memory"); __syncthreads();
                    if (tid == 0) { __builtin_amdgcn_fence(__ATOMIC_RELEASE, "agent"); asm volatile("s_waitcnt vmcnt(0)" ::: "memory"); (void)xb_add(ctxcnt, 1u); } }
                __syncthreads();
            }
            __syncthreads();
            bf16_t* U = (bf16_t*)lds;
            bf16_t* DF = (bf16_t*)(lds + 45056);
            constexpr int US = 264;
            const int npool = pass == 0 ? nctx : 512;
            const bf16_t* pwt = POOLWT + (size_t)l * 4 * 4096;
            const int pg = wave >> 1, pth = wave & 1, pfr = lane & 15, pfq = lane >> 4;
            bf16x8 bfv[2][4]; f32x4 psv[4];
#pragma unroll
            for (int ks = 0; ks < 2; ++ks)
#pragma unroll
                for (int n = 0; n < 4; ++n) bfv[ks][n] = *(const bf16x8*)(pwt + (size_t)pg * 4096 + (16 * n + pfr) * 64 + 32 * ks + 8 * pfq);
#pragma unroll
            for (int n = 0; n < 4; ++n) psv[n] = *(const f32x4*)(INP(I_POOLS) + l * 256 + pg * 64 + 16 * n + 4 * pfq);
            bf16x8 uv[5] = {};
#define POOL_DEC(it_, b_, s0_, t0_, Ls_) do { if (pass == 1) { b_ = (it_) >> 6; t0_ = ((it_) & 63) * 64; s0_ = b_ * LT + LC; Ls_ = L; } else { b_ = (it_) >> 2; t0_ = ((it_) & 3) * 64; s0_ = b_ * LT; Ls_ = LC; } } while (0)
#define POOL_LOAD(it_) do { int b_, s0_, t0_, Ls_; POOL_DEC(it_, b_, s0_, t0_, Ls_); (void)b_; _Pragma("unroll") for (int i = 0; i < 5; ++i) { const int t = t0_ - 8 + (tid >> 5) + 16 * i; \
                bf16x8 v = {0, 0, 0, 0, 0, 0, 0, 0}; if (t >= 0 && t < Ls_) v = *(const bf16x8*)(P + (size_t)(s0_ + t) * INW + OFF_PU + (tid & 31) * 8); uv[i] = v; } } while (0)
            int it = pass == 0 ? (vcu + GW - 32) % GW : (vcu + GW - 128) % GW;
            if (it < npool) POOL_LOAD(it);
            for (; it < npool; it += GW) {
                int b, s0, t0, Ls; POOL_DEC(it, b, s0, t0, Ls); (void)b;
#pragma unroll
                for (int i = 0; i < 5; ++i) *(bf16x8*)(U + ((tid >> 5) + 16 * i) * US + (tid & 31) * 8) = uv[i];
                __syncthreads();
                if (it + GW < npool) POOL_LOAD(it + GW);
#pragma unroll 1
                for (int g = 0; g < 4; ++g) { const int tt = tid >> 3, c8 = g * 64 + (tid & 7) * 8, hw = 1 << g;
                    const int t = t0 + tt; int lo = t - hw; lo = lo < 0 ? 0 : lo; int hi2 = t + hw; hi2 = hi2 > Ls ? Ls : hi2;
                    float s[8] = {0.f, 0.f, 0.f, 0.f, 0.f, 0.f, 0.f, 0.f};
                    for (int q = lo; q < hi2; ++q) { const bf16x8 v = *(const bf16x8*)(U + (q - t0 + 8) * US + c8);
#pragma unroll
                        for (int z = 0; z < 8; ++z) s[z] += bf2f((bf16_t)v[z]); }
                    const float inv = 1.0f / (float)(hi2 - lo);
                    const bf16x8 me = *(const bf16x8*)(U + (tt + 8) * US + c8);
                    u32x4 o; float dv[8];
#pragma unroll
                    for (int z = 0; z < 8; ++z) dv[z] = s[z] * inv - bf2f((bf16_t)me[z]);
                    o.x = cvt_pk_bf16(dv[0], dv[1]); o.y = cvt_pk_bf16(dv[2], dv[3]); o.z = cvt_pk_bf16(dv[4], dv[5]); o.w = cvt_pk_bf16(dv[6], dv[7]);
                    *(u32x4*)(DF + tt * US + c8) = o; }
                __syncthreads();
                {
                    f32x4 acc[2][4];
#pragma unroll
                    for (int m = 0; m < 2; ++m)
#pragma unroll
                        for (int n = 0; n < 4; ++n) acc[m][n] = (f32x4){0.f, 0.f, 0.f, 0.f};
#pragma unroll
                    for (int ks = 0; ks < 2; ++ks) {
                        bf16x8 af[2];
#pragma unroll
                        for (int m = 0; m < 2; ++m) af[m] = *(const bf16x8*)(DF + (32 * pth + 16 * m + pfr) * US + pg * 64 + 32 * ks + 8 * pfq);
#pragma unroll
                        for (int m = 0; m < 2; ++m)
#pragma unroll
                            for (int n = 0; n < 4; ++n) acc[m][n] = __builtin_amdgcn_mfma_f32_16x16x32_bf16(bfv[ks][n], af[m], acc[m][n], 0, 0, 0);
                    }
#pragma unroll
                    for (int m = 0; m < 2; ++m)
#pragma unroll
                        for (int n = 0; n < 4; ++n) {
                            const int jc = pg * 64 + 16 * n + 4 * pfq;
                            const f32x4 r = acc[m][n] * psv[n];
                            u32x2 o; o.x = cvt_pk_bf16(r[0], r[1]); o.y = cvt_pk_bf16(r[2], r[3]);
                            *(u32x2*)(MIX + (size_t)(s0 + t0 + 32 * pth + 16 * m + pfr) * D + 512 + jc) = o;
                        }
                }
                if (g2c && pass == 0 && rep_ == 0) { asm volatile("s_waitcnt vmcnt(0)" ::: "memory"); __syncthreads();
                    if (tid == 0) { __builtin_amdgcn_fence(__ATOMIC_RELEASE, "agent"); asm volatile("s_waitcnt vmcnt(0)" ::: "memory"); (void)xb_add(ctxcnt, 1u); } }
                __syncthreads();
            }
#undef POOL_DEC
#undef POOL_LOAD
            __syncthreads();
            }
        }
        GRID_BAR();
        PH(6) REP(6) { WSPTRS(); const float* modl = MODV + (size_t)l * 9 * 6144;
            pg8::DenseSched S; S.init(M, D, D, G, bx, WOUT + (size_t)l * 1024 * 1024, last || G == 256);
            pg8::EpiG2 E{INP(I_X), INP(I_CTX), XB, modl, l == 0};
            pg8::gemm_phase<pg8::EpiG2, pg8::DenseSched>(ldsl, (const char*)MIX, D, S, E, wave0);
        }
        GRID_BAR();
        PH(7) REP(7) { WSPTRS(); const float* modl = MODV + (size_t)l * 9 * 6144;
            float* RWE = (float*)lds;
            float* PART = (float*)(lds_all + LC_PART);
            int* RI = (int*)(lds_all + LC_RI);
            float* RGt = (float*)(lds_all + LC_RG);
            volatile LAS int* lcnt = (volatile LAS int*)(ldsc + LC_LCNT);
            volatile LAS int* lbase = (volatile LAS int*)(ldsc + LC_BASE);
            const float* nw = INP(I_N2W) + l * D; const float* rwp = INP(I_RW); const float* rbp = INP(I_RB);
            for (int vb = vcu; vb < 256; vb += G) {
                const int b = vb >> 5, q = vb & 31; int row0, nrows; bool isctx = false;
                if (last) { row0 = b * LT + LC + q * 128; nrows = 128; }
                else if (q < 2) { isctx = true; row0 = b * LT + q * 128; nrows = 128; }
                else { row0 = b * LT + LC + (q - 2) * 137; nrows = L - (q - 2) * 137; nrows = nrows > 137 ? 137 : nrows; }
                const float* mod = modl + (size_t)(isctx ? 8 : b) * 6144;
                f32x4 wsc[4], shv[4];
#pragma unroll
                for (int jj = 0; jj < 4; ++jj) { const int cc = 4 * lane + 256 * jj; wsc[jj] = *(const f32x4*)(nw + cc) * (*(const f32x4*)(mod + 4096 + cc) + 1.0f); shv[jj] = *(const f32x4*)(mod + 3072 + cc); }
                if (tid < 16) lcnt[tid] = 0;
                float bp[16];
#pragma unroll
                for (int e = 0; e < 16; ++e) bp[e] = 0.f;
#pragma unroll
                for (int hh = 0; hh < 2; ++hh) {
                    const int k = tid + 512 * hh;
                    const float wk = nw[k] * (mod[4096 + k] + 1.0f), shk = mod[3072 + k];
                    float* dstp = RWE + (size_t)(((k >> 2) & 63) + 64 * ((k & 3) + 4 * (k >> 8))) * 20;
#pragma unroll
                    for (int e4 = 0; e4 < 4; ++e4) { const f32x4 r = *(const f32x4*)(rwp + k * 16 + 4 * e4); *(f32x4*)(dstp + 4 * e4) = r * wk;
                        bp[4 * e4 + 0] += shk * r[0]; bp[4 * e4 + 1] += shk * r[1]; bp[4 * e4 + 2] += shk * r[2]; bp[4 * e4 + 3] += shk * r[3]; }
                }
#pragma unroll
                for (int e = 0; e < 16; ++e) { const float t = wave_sum(bp[e], lane); if (lane == 0) PART[wave * 16 + e] = t; }
                __syncthreads();
                float rbv[16]; float lgb_lane = 0.f;
#pragma unroll
                for (int w = 0; w < 8; ++w) lgb_lane += PART[w * 16 + ((lane >> 2) & 15)];
#pragma unroll
                for (int e = 0; e < 16; ++e) rbv[e] = __int_as_float(__builtin_amdgcn_readfirstlane(__float_as_int(rbp[e])));
                float* LGS = (float*)(lds + 81920) + wave * (18 * 16);
                const bf16_t* xbase = XB + (size_t)row0 * D;
                f32x4 xv[4] = {};
                if (wave < nrows) {
#pragma unroll
                    for (int jj = 0; jj < 4; ++jj) xv[jj] = bf4_to_f4(*(const u32x2*)(xbase + (size_t)wave * D + 4 * lane + 256 * jj));
                }
                for (int rr = wave; rr < nrows; rr += 8) {
                    f32x4 xn[4] = {};
                    if (rr + 8 < nrows) {
#pragma unroll
                        for (int jj = 0; jj < 4; ++jj) xn[jj] = bf4_to_f4(*(const u32x2*)(xbase + (size_t)(rr + 8) * D + 4 * lane + 256 * jj));
                    }
                    float ss = 0.f; f32x2 d2[8];
#pragma unroll
                    for (int e = 0; e < 8; ++e) d2[e] = (f32x2){0.f, 0.f};
#pragma unroll
                    for (int jj = 0; jj < 4; ++jj) {
                        ss += (xv[jj][0] * xv[jj][0] + xv[jj][1] * xv[jj][1]) + (xv[jj][2] * xv[jj][2] + xv[jj][3] * xv[jj][3]);
                        f32x4 rr4[4][4];
#pragma unroll
                        for (int i = 0; i < 4; ++i) { const float* rw = RWE + (size_t)(lane + 64 * (i + 4 * jj)) * 20;
#pragma unroll
                            for (int q4 = 0; q4 < 4; ++q4) rr4[i][q4] = *(const f32x4*)(rw + 4 * q4); }
#pragma unroll
                        for (int i = 0; i < 4; ++i) { const f32x2 xk2 = (f32x2){xv[jj][i], xv[jj][i]};
#pragma unroll
                            for (int q4 = 0; q4 < 4; ++q4) { d2[2 * q4] = __builtin_elementwise_fma((f32x2){rr4[i][q4][0], rr4[i][q4][1]}, xk2, d2[2 * q4]); d2[2 * q4 + 1] = __builtin_elementwise_fma((f32x2){rr4[i][q4][2], rr4[i][q4][3]}, xk2, d2[2 * q4 + 1]); } }
                        __builtin_amdgcn_sched_barrier(0);
                    }
                    float dot[16];
#pragma unroll
                    for (int e = 0; e < 8; ++e) { dot[2 * e] = d2[e][0]; dot[2 * e + 1] = d2[e][1]; }
                    ss = wave_sum(ss, lane);
                    float t8[8], t4[4], t2[2], dv;
#pragma unroll
                    for (int i = 0; i < 8; ++i) { auto rr2 = __builtin_amdgcn_permlane32_swap(__float_as_uint(dot[i]), __float_as_uint(dot[i + 8]), false, false); t8[i] = __uint_as_float(rr2[0]) + __uint_as_float(rr2[1]); }
                    { const bool b4 = (lane & 16) != 0, b3 = (lane & 8) != 0, b2 = (lane & 4) != 0;
#pragma unroll
                      for (int i = 0; i < 4; ++i) { const float keep = b4 ? t8[i + 4] : t8[i], send = b4 ? t8[i] : t8[i + 4]; t4[i] = keep + shfl_xor_l(send, lane, 16); }
#pragma unroll
                      for (int i = 0; i < 2; ++i) { const float keep = b3 ? t4[i + 2] : t4[i], send = b3 ? t4[i] : t4[i + 2]; t2[i] = keep + shfl_xor_l(send, lane, 8); }
                      { const float keep = b2 ? t2[1] : t2[0], send = b2 ? t2[0] : t2[1]; dv = keep + shfl_xor_l(send, lane, 4); }
                      dv += shfl_xor_l(dv, lane, 2); dv += shfl_xor_l(dv, lane, 1); }
                    const float rstd = __builtin_amdgcn_rsqf(ss * (1.0f / D) + EPS);
                    const int row = row0 + rr;
#pragma unroll
                    for (int jj = 0; jj < 4; ++jj) {
                        const f32x4 hv = xv[jj] * rstd * wsc[jj] + shv[jj];
                        *(unsigned*)(H8 + (size_t)row * D + 4 * lane + 256 * jj) = pk4_fp8(hv[0], hv[1], hv[2], hv[3]);
                    }
                    if ((lane & 3) == 0) LGS[(rr >> 3) * 16 + (lane >> 2)] = dv * rstd + lgb_lane;
#pragma unroll
                    for (int jj = 0; jj < 4; ++jj) xv[jj] = xn[jj];
                }
                asm volatile("s_waitcnt lgkmcnt(0)" ::: "memory");
                {
                    const int rr = wave + 8 * lane;
                    if (rr < nrows) {
                        float sg[16], sel[16];
#pragma unroll
                        for (int e4 = 0; e4 < 4; ++e4) { const f32x4 lg4 = *(const f32x4*)(LGS + lane * 16 + 4 * e4);
#pragma unroll
                            for (int q4 = 0; q4 < 4; ++q4) { const int e = 4 * e4 + q4; sg[e] = __builtin_amdgcn_rcpf(1.0f + __builtin_amdgcn_exp2f(-lg4[q4] * LOG2E)); sel[e] = sg[e] + rbv[e]; } }
                        float best = -1e30f; int gi = 0;
#pragma unroll
                        for (int g = 0; g < 4; ++g) {
                            float m1 = -1e30f, m2 = -1e30f;
#pragma unroll
                            for (int qq = 0; qq < 4; ++qq) { const float x_ = sel[4 * g + qq]; if (x_ > m1) { m2 = m1; m1 = x_; } else if (x_ > m2) m2 = x_; }
                            const float gs = m1 + m2; if (gs > best) { best = gs; gi = g; }
                        }
                        float v1 = -1e30f, v2 = -1e30f; int i1 = 0, i2 = 0; float sa = 0.f, sb2 = 0.f;
#pragma unroll
                        for (int g = 0; g < 4; ++g)
#pragma unroll
                            for (int qq = 0; qq < 4; ++qq) if (g == gi) {
                                const float x_ = sel[4 * g + qq], sx = sg[4 * g + qq];
                                if (x_ > v1) { v2 = v1; i2 = i1; sb2 = sa; v1 = x_; i1 = 4 * g + qq; sa = sx; } else if (x_ > v2) { v2 = x_; i2 = 4 * g + qq; sb2 = sx; }
                            }
                        const float rden = 1.0f / (sa + sb2);
                        const int p0 = __hip_atomic_fetch_add((LAS int*)&lcnt[i1], 1, __ATOMIC_RELAXED, __HIP_MEMORY_SCOPE_WORKGROUP), p1 = __hip_atomic_fetch_add((LAS int*)&lcnt[i2], 1, __ATOMIC_RELAXED, __HIP_MEMORY_SCOPE_WORKGROUP);
                        RI[rr * 4 + 0] = i1; RI[rr * 4 + 1] = i2; RI[rr * 4 + 2] = p0; RI[rr * 4 + 3] = p1; RGt[rr * 2] = sa * rden; RGt[rr * 2 + 1] = sb2 * rden;
                    }
                }
                __syncthreads();
                if (tid < 16) { const int n = lcnt[tid]; lbase[tid] = n ? (int)__hip_atomic_fetch_add(ctl + CW_CNT + (l * 16 + tid) * 64, (unsigned)n, __ATOMIC_RELAXED, __HIP_MEMORY_SCOPE_AGENT) : 0; }
                __syncthreads();
                for (int qq = tid; qq < nrows * 2; qq += 512) {
                    const int rr = qq >> 1, k = qq & 1, row = row0 + rr;
                    const int e = RI[rr * 4 + k]; const int pos = lbase[e] + RI[rr * 4 + 2 + k]; const int pair = row * 2 + k; TOK[(size_t)e * CAP + pos] = pair; GATE[pair] = RGt[rr * 2 + k];
                }
                __syncthreads();
            }
        }
        GRID_BAR();
        PH(8) REP(8) { WSPTRS();
            volatile LAS int* tp = (volatile LAS int*)(ldsc + LC_TP);
            volatile LAS int* cn = (volatile LAS int*)(ldsc + LC_CNT);
            if (tid == 0) { int acc_ = 0; for (int e = 0; e < 16; ++e) { const int n = (int)__hip_atomic_load(ctl + CW_CNT + (l * 16 + e) * 64, __ATOMIC_RELAXED, __HIP_MEMORY_SCOPE_AGENT); cn[e] = n; tp[e] = acc_; acc_ += (n + 255) >> 8; } tp[16] = acc_; }
            __syncthreads();
            {
                pg8::MoeSched<true> S{G, bx, NGU / 256, D, (const char*)(WGU + (size_t)l * 16 * NGU * 1024), (size_t)NGU * 1024, (const LAS int*)tp, (const LAS int*)cn, TOK};
                pg8::EpiE1 E{ACT};
                pg8::gemm_phase<pg8::EpiE1, pg8::MoeSched<true>, true>(ldsl, (const char*)H8, D, S, E, wave0);
            }
            GRID_BAR();
            {
                pg8::MoeSched<false> S{G, bx, D / 256, DE, (const char*)(WDN + (size_t)l * 16 * 1024 * DE), (size_t)1024 * DE, (const LAS int*)tp, (const LAS int*)cn, TOK};
                pg8::EpiE2 E{Y2, TOK, GATE, (const LAS int*)cn};
                pg8::gemm_phase<pg8::EpiE2, pg8::MoeSched<false>, true>(ldsl, (const char*)ACT, DE, S, E, wave0);
            }
        }
        GRID_BAR();
    }
    PH(9) REP(9) { WSPTRS();
        const float* g2b = MODV + (size_t)3 * 9 * 6144 + 5 * 1024;
        for (int r = gw; r < NB * L; r += NGW) {
            const int b = r / L, t = r - b * L; const int row = b * LT + LC + t;
            float* xr = OUT + (size_t)r * D;
            const float* g2 = g2b + (size_t)b * 6144;
            const unsigned char* y0 = Y2 + (size_t)(2 * row) * D; const unsigned char* y1 = y0 + D;
            f32x4 v[4]; float ss = 0.f;
#pragma unroll
            for (int jj = 0; jj < 4; ++jj) {
                const int cc = 4 * lane + 256 * jj;
                const f32x4 a = fp8x4_to_f4(*(const unsigned*)(y0 + cc)), bb = fp8x4_to_f4(*(const unsigned*)(y1 + cc)), g = *(const f32x4*)(g2 + cc) * pg8::YINV;
                v[jj] = bf4_to_f4(*(const u32x2*)(XB + (size_t)row * D + cc)) + g * (a + bb);
                ss += (v[jj][0] * v[jj][0] + v[jj][1] * v[jj][1]) + (v[jj][2] * v[jj][2] + v[jj][3] * v[jj][3]);
            }
            ss = wave_sum(ss, lane);
            const float rstd = 1.0f / sqrtf(ss * (1.0f / D) + EPS);
#pragma unroll
            for (int jj = 0; jj < 4; ++jj) { const int cc = 4 * lane + 256 * jj; *(f32x4*)(xr + cc) = v[jj] * rstd * *(const f32x4*)(INP(I_FNW) + cc); }
        }
    }
}

extern "C" void kernel_launch(void* const* d_in, const int* in_sizes, int n_in, void* d_out, int out_size, void* d_ws, size_t ws_size, hipStream_t stream) {
    static int grid = 0;
    if (grid == 0) {
        if (n_in != 23 || out_size != NB * L * D || ws_size < WS_END) { fprintf(stderr, "kernel_launch: unexpected shapes (n_in %d out %d ws %zu, need ws >= %zu)\n", n_in, out_size, ws_size, (size_t)WS_END); grid = -1; return; }
        int dev = 0, cus = 0, per_cu = 0;
        if (hipGetDevice(&dev) != hipSuccess || hipDeviceGetAttribute(&cus, hipDeviceAttributeMultiprocessorCount, dev) != hipSuccess) { grid = -1; return; }
        if (hipFuncSetAttribute((const void*)fwd_kernel, hipFuncAttributeMaxDynamicSharedMemorySize, LDS_BYTES) != hipSuccess) { fprintf(stderr, "kernel_launch: hipFuncSetAttribute failed\n"); grid = -1; return; }
        if (hipOccupancyMaxActiveBlocksPerMultiprocessor(&per_cu, (const void*)fwd_kernel, 512, LDS_BYTES) != hipSuccess || per_cu < 1) fprintf(stderr, "kernel_launch: occupancy query reports %d\n", per_cu);
        (void)hipGetLastError();
        grid = cus;
    }
    if (grid < 0) return;
    (void)hipMemsetAsync((char*)d_ws + WS_CTL, 0, CTL_ZERO_BYTES, stream);
    Params p{};
    const float** pp = (const float**)&p;
    for (int i = 0; i < 23; ++i) pp[i] = (const float*)d_in[i];
    p.out = (float*)d_out; p.ws = (unsigned char*)d_ws;
    hipLaunchKernelGGL(fwd_kernel, dim3(grid), dim3(512), LDS_BYTES, stream, p);
    const hipError_t le = hipPeekAtLastError();
    if (le != hipSuccess) fprintf(stderr, "kernel_launch: launch failed: %s\n", hipGetErrorName(le));
}
```

```cpp
#include <hip/hip_runtime.h>
#include <cstdio>
#include <cstdint>

#define LAS __attribute__((address_space(3)))
#define GAS __attribute__((address_space(1)))
typedef unsigned short bf16_t;
typedef short bf16x8 __attribute__((ext_vector_type(8)));
typedef short s16x4 __attribute__((ext_vector_type(4)));
typedef float f32x2 __attribute__((ext_vector_type(2)));
typedef float f32x4 __attribute__((ext_vector_type(4)));
typedef float f32x16 __attribute__((ext_vector_type(16)));
typedef unsigned u32x2 __attribute__((ext_vector_type(2)));
typedef unsigned u32x4 __attribute__((ext_vector_type(4)));

constexpr int D = 1024, NB = 8, L = 4096, LC = 256, LT = L + LC, M = NB * LT;
constexpr int DEPTH = 4, INW = 2816;
constexpr int OFF_DQ = 0, OFF_DK = 512, OFF_DV = 1024, OFF_PU = 1536, OFF_RQ = 1792, OFF_RK = 2048, OFF_RV = 2304, OFF_RG = 2560;
constexpr int NE = 16, DE = 768, NGU = 2 * DE;
constexpr int NCH = LT / 128;
constexpr int CAP = M;
constexpr int ACT_ROWS = 73728;
constexpr float EPS = 1e-6f;
constexpr float LOG2E = 1.4426950408889634f;

constexpr size_t MiB = 1u << 20;
constexpr size_t WS_CTL = 0, CTL_ZERO_BYTES = 1 * MiB;
constexpr size_t WS_MOD = 1 * MiB;
constexpr size_t WS_ROPE = 2 * MiB;
constexpr size_t WS_POOLW = 2 * MiB + 16384;
constexpr size_t WS_GATE = 3 * MiB;
constexpr size_t WS_TOK = 4 * MiB;
constexpr size_t WS_XC = 8 * MiB;
constexpr size_t WS_KV = 16 * MiB;
constexpr size_t WS_ST = 50 * MiB;
constexpr size_t WS_WIN = 68 * MiB;
constexpr size_t WS_WOUT = 90 * MiB;
constexpr size_t WS_WGU = 98 * MiB;
constexpr size_t WS_WDN = 194 * MiB;
constexpr size_t WS_H8 = 242 * MiB;
constexpr size_t WS_QK8 = 276 * MiB;
constexpr size_t WS_VT8 = 312 * MiB;
constexpr size_t WS_H = 330 * MiB;
constexpr size_t WS_XB = 386 * MiB;
constexpr size_t WS_P = 454 * MiB;
constexpr size_t WS_MIX = 641 * MiB;
constexpr size_t WS_ACT = WS_P;
constexpr size_t WS_Y2 = 562 * MiB;
constexpr size_t WS_K8T = 709 * MiB;
constexpr size_t WS_END = 727 * MiB;
constexpr size_t K8T_OFF = WS_K8T - WS_QK8;
static_assert(WS_ACT + (size_t)ACT_ROWS * DE * 2 <= WS_Y2 && WS_Y2 + (size_t)2 * M * D * 2 <= WS_END, "ws map");
static_assert(WS_P + (size_t)M * INW * 2 <= WS_MIX && WS_MIX + (size_t)M * D * 2 <= WS_END, "ws map");
constexpr int CW_TMO = 0;
constexpr int CW_BAR = 4096;
constexpr int CW_CTX = 8192;
constexpr int CW_CNT = 16384;

constexpr int RING_BYTES = 131072;
constexpr int LDSCTL_OFF = 0, LDSCTL_BYTES = 8192, RING_OFF = LDSCTL_BYTES;
constexpr int LDS_BYTES = 147456;
constexpr int LC_BARW = 0;
constexpr int LC_TP = 64;
constexpr int LC_CNT = 160;
constexpr int LC_LCNT = 256;
constexpr int LC_BASE = 320;
constexpr int LC_PTR = 512;
constexpr int LC_PART = 1024;
constexpr int LC_RG = 1536;
constexpr int LC_RI = 3072;

__device__ __forceinline__ int opaque_int(int v) { asm volatile("" : "+s"(v)); return v; }
__device__ __forceinline__ int opaque_tid(int wave0) { int w = wave0; asm volatile("" : "+s"(w)); int t; asm volatile("v_mbcnt_lo_u32_b32 %0, -1, 0\n\tv_mbcnt_hi_u32_b32 %0, -1, %0" : "=&v"(t)); return t + (w << 6); }
__device__ __forceinline__ float bf2f(bf16_t v) { return __uint_as_float(((unsigned)v) << 16); }
__device__ __forceinline__ unsigned cvt_pk_bf16(float lo, float hi) { unsigned r; asm volatile("v_cvt_pk_bf16_f32 %0, %1, %2" : "=v"(r) : "v"(lo), "v"(hi)); return r; }
__device__ __forceinline__ bf16_t f2bf(float f) { return (bf16_t)(cvt_pk_bf16(f, 0.f) & 0xffffu); }
__device__ __forceinline__ float shfl_xor_l(float v, int lane, int o) { return __int_as_float(__builtin_amdgcn_ds_bpermute((lane ^ o) << 2, __float_as_int(v))); }
__device__ __forceinline__ float wave_sum(float v, int lane) {
#pragma unroll
    for (int o = 1; o < 64; o <<= 1) v += shfl_xor_l(v, lane, o);
    return v;
}
__device__ __forceinline__ float half_sum32(float v, int lane) {
#pragma unroll
    for (int o = 1; o < 32; o <<= 1) v += shfl_xor_l(v, lane, o);
    return v;
}
__device__ __forceinline__ unsigned pk4_fp8(float a, float b, float c, float d) { int w = 0; w = __builtin_amdgcn_cvt_pk_fp8_f32(a, b, w, false); w = __builtin_amdgcn_cvt_pk_fp8_f32(c, d, w, true); return (unsigned)w; }
__device__ __forceinline__ f32x4 fp8x4_to_f4(unsigned w) { const f32x2 lo = __builtin_amdgcn_cvt_pk_f32_fp8((int)w, false), hi = __builtin_amdgcn_cvt_pk_f32_fp8((int)w, true); return (f32x4){lo[0], lo[1], hi[0], hi[1]}; }
__device__ __forceinline__ float silu_f(float g) { return g * __builtin_amdgcn_rcpf(1.0f + __builtin_amdgcn_exp2f(-g * LOG2E)); }
__device__ __forceinline__ f32x4 bf4_to_f4(u32x2 a) { f32x4 r; r[0] = __uint_as_float(a.x << 16); r[1] = __uint_as_float(a.x & 0xffff0000u); r[2] = __uint_as_float(a.y << 16); r[3] = __uint_as_float(a.y & 0xffff0000u); return r; }

#define XB_TMO      128
#define XB_XCNT(j)  (256  + 64 * (j))
#define XB_XSUB(j)  (1280 + 64 * (j))
#define XB_XGEN(j)  (2304 + 64 * (j))
#define XB_TOP      3328
#define XB_TOPGEN   3392
#define XCD_BAR_WORDS 3456
#define XB_SPIN_CAP (1u << 18)
__device__ __forceinline__ unsigned xb_ld(unsigned* p)              { return __hip_atomic_load(p, __ATOMIC_RELAXED, __HIP_MEMORY_SCOPE_AGENT); }
__device__ __forceinline__ unsigned xb_add(unsigned* p, unsigned v) { return __hip_atomic_fetch_add(p, v, __ATOMIC_RELAXED, __HIP_MEMORY_SCOPE_AGENT); }
__device__ __forceinline__ unsigned xb_xcc_id() { return (unsigned)__builtin_amdgcn_s_getreg((3 << 11) | 20) & 0xFu; }
#define XB_SPIN(cond, bar) do { unsigned _sp = 0; while (cond) { __builtin_amdgcn_s_sleep(1); \
    if ((++_sp & 255u) == 0u) { if (xb_ld(&(bar)[XB_TMO])) break; if (_sp > XB_SPIN_CAP) { atomicAdd(&(bar)[XB_TMO], 1u); break; } } } } while (0)
struct XcdBarrier { unsigned* bar; unsigned x; volatile LAS unsigned* st; };
__device__ __forceinline__ XcdBarrier xcd_barrier_post(unsigned* bar, volatile LAS unsigned* st) {
    XcdBarrier b; b.bar = bar; b.x = xb_xcc_id(); b.st = st;
    if (threadIdx.x == 0) (void)xb_add(&bar[XB_XCNT(b.x)], 1u);
    return b;
}
__device__ __forceinline__ void xcd_barrier_complete(unsigned* bar, unsigned x, unsigned& nloc, unsigned& nx) {
    const unsigned G = gridDim.x * gridDim.y * gridDim.z;
    unsigned sum, cnt, mine, sp = 0u;
    for (;;) {
        sum = 0u; cnt = 0u; mine = 0u;
#pragma unroll
        for (unsigned j = 0; j < 16; ++j) { const unsigned c = xb_ld(&bar[XB_XCNT(j)]); sum += c; cnt += (c > 0u) ? 1u : 0u; mine = (j == x) ? c : mine; }
        if (sum == G) break;
        __builtin_amdgcn_s_sleep(1);
        if ((++sp & 255u) == 0u) { if (xb_ld(&bar[XB_TMO])) break; if (sp > XB_SPIN_CAP) { atomicAdd(&bar[XB_TMO], 1u); break; } }
    }
    nloc = mine > 0u ? mine : 1u; nx = cnt > 0u ? cnt : 1u;
}
__device__ __forceinline__ void xcd_barrier(const XcdBarrier& b) {
    asm volatile("s_waitcnt vmcnt(0)" ::: "memory");
    __syncthreads();
    if (threadIdx.x == 0) {
        unsigned long long bv_ = (unsigned long long)b.bar; unsigned bx_ = b.x;
        asm volatile("" : "+s"(bv_), "+s"(bx_));
        unsigned* bar = (unsigned*)(GAS unsigned*)bv_;
        __builtin_amdgcn_s_waitcnt(0);
        unsigned nloc = b.st[0], nx = b.st[1];
        if (nloc == 0u) { xcd_barrier_complete(bar, bx_, nloc, nx); b.st[0] = nloc; b.st[1] = nx; }
        const unsigned old = xb_add(&bar[XB_XSUB(bx_)], 1u);
        const unsigned gen = old / nloc;
        if (old + 1u == (gen + 1u) * nloc) {
            __builtin_amdgcn_fence(__ATOMIC_RELEASE, "agent");
            asm volatile("s_waitcnt vmcnt(0)" ::: "memory");
            const unsigned og = xb_add(&bar[XB_TOP], 1u);
            const unsigned tg = og / nx;
            if (og + 1u == (tg + 1u) * nx) xb_add(&bar[XB_TOPGEN], 1u);
            else XB_SPIN(xb_ld(&bar[XB_TOPGEN]) == tg, bar);
            __builtin_amdgcn_fence(__ATOMIC_ACQUIRE, "agent");
            xb_add(&bar[XB_XGEN(bx_)], 1u);
            asm volatile("s_waitcnt vmcnt(0)" ::: "memory");
        } else {
            XB_SPIN(xb_ld(&bar[XB_XGEN(bx_)]) == gen, bar);
            __builtin_amdgcn_fence(__ATOMIC_ACQUIRE, "agent");
            asm volatile("s_waitcnt vmcnt(0)" ::: "memory");
        }
    }
    __syncthreads();
}

namespace pg8 {
constexpr int BM = 256, BK = 64, HALF = 128, HTB = HALF * BK * 2, STAGE_BYTES = 8 * HTB;
__host__ __device__ __forceinline__ int lds_byte(int r, int c) { const int st = (r >> 4) * 2 + (c >> 5), rr = r & 15, cc = c & 31, ob = rr * 64 + cc * 2; return st * 1024 + (ob ^ (((ob >> 9) & 1) << 5)); }
__host__ __device__ __forceinline__ void stage_rc(int b, int& R, int& C) { const int st = b / 1024, sb = b % 1024, swz = sb ^ (((sb >> 9) & 1) << 5); R = (st >> 1) * 16 + swz / 64; C = (st & 1) * 32 + (swz % 64) / 2; }
__host__ __device__ __forceinline__ int perm32(int rho) { const int n = rho >> 4, i = rho & 15; return 8 * (i >> 2) + 4 * n + (i & 3); }
struct Unit { int pm, pn, e, rt; };
typedef int v8i32 __attribute__((ext_vector_type(8)));
typedef int v4i32 __attribute__((ext_vector_type(4)));
__device__ __forceinline__ v8i32 cat8(bf16x8 a, bf16x8 b) { const v4i32 x = __builtin_bit_cast(v4i32, a), y = __builtin_bit_cast(v4i32, b); return __builtin_shufflevector(x, y, 0, 1, 2, 3, 4, 5, 6, 7); }

template <class Epi, class Sched, bool FP8 = false>
__device__ __forceinline__ void gemm_phase(LAS unsigned char* lds, const char* Abase, const int K, const Sched& S, const Epi& E, const int wave0) {
    const int tid = opaque_tid(wave0), wid = __builtin_amdgcn_readfirstlane(tid >> 6), lane = tid & 63, wr = wid >> 2, wc = wid & 3, fr = lane & 15, fq = lane >> 4;
    const int rowB = FP8 ? K : 2 * K;
    const int nt = rowB / (BK * 2);
    int RA[2], CA[2]; unsigned voffB[2];
#pragma unroll
    for (int i = 0; i < 2; ++i) { int R, C; stage_rc(tid * 16 + i * 8192, R, C); const int Rb = (R & ~31) + perm32(R & 31); RA[i] = R; CA[i] = C; voffB[i] = (unsigned)(Rb * rowB + C * 2); }
    const size_t kstep = (size_t)(BK * 2);
    const size_t hstep = (size_t)HALF * rowB;
    const unsigned ldsw = (unsigned)wid * 1024u;
    const int aoff = lds_byte(wr * 64 + fr, fq * 8), boff = lds_byte(wc * 32 + fr, fq * 8);
#define PG8_SA(b, h) (((b) * 2 + (h)) * HTB)
#define PG8_SB(b, h) ((4 + (b) * 2 + (h)) * HTB)
#define PG8_STAGE_B(bufoff, gbase) do { _Pragma("unroll") for (int _i = 0; _i < 2; ++_i) \
        __builtin_amdgcn_global_load_lds((const unsigned*)((const char*)(gbase) + voffB[_i]), (LAS unsigned*)(lds + (bufoff) + ldsw + _i * 8192), 16, 0, 0); } while (0)
#define PG8_STAGE_A(bufoff, offs, kb) do { _Pragma("unroll") for (int _i = 0; _i < 2; ++_i) \
        __builtin_amdgcn_global_load_lds((const unsigned*)((Abase + (size_t)(unsigned)(kb)) + (offs)[_i]), (LAS unsigned*)(lds + (bufoff) + ldsw + _i * 8192), 16, 0, 0); } while (0)
#define PG8_LDA(dst, b, h) do { if constexpr (FP8) { _Pragma("unroll") for (int m = 0; m < 4; ++m) dst##8[m] = __builtin_shufflevector(*(const LAS v4i32*)(lds + PG8_SA(b, h) + aoff + m * 2048), *(const LAS v4i32*)(lds + PG8_SA(b, h) + aoff + m * 2048 + 1024), 0, 1, 2, 3, 4, 5, 6, 7); } \
    else { _Pragma("unroll") for (int m = 0; m < 4; ++m) _Pragma("unroll") for (int k = 0; k < 2; ++k) dst[m][k] = *(const LAS bf16x8*)(lds + PG8_SA(b, h) + aoff + m * 2048 + k * 1024); } } while (0)
#define PG8_LDB(dst, b, h) do { if constexpr (FP8) { _Pragma("unroll") for (int n = 0; n < 2; ++n) dst##8[n] = __builtin_shufflevector(*(const LAS v4i32*)(lds + PG8_SB(b, h) + boff + n * 2048), *(const LAS v4i32*)(lds + PG8_SB(b, h) + boff + n * 2048 + 1024), 0, 1, 2, 3, 4, 5, 6, 7); } \
    else { _Pragma("unroll") for (int n = 0; n < 2; ++n) _Pragma("unroll") for (int k = 0; k < 2; ++k) dst[n][k] = *(const LAS bf16x8*)(lds + PG8_SB(b, h) + boff + n * 2048 + k * 1024); } } while (0)
#define PG8_MMA(ai, bj, At, Bt) do { __builtin_amdgcn_s_setprio(1); _Pragma("unroll") for (int m = 0; m < 4; ++m) _Pragma("unroll") for (int n = 0; n < 2; ++n) { \
        if constexpr (FP8) asm volatile("v_mfma_scale_f32_16x16x128_f8f6f4 %0, %1, %2, %0, %3, %3 op_sel_hi:[0,0,0]" : "+v"(acc[ai][bj][m][n]) : "v"(Bt##8[n]), "v"(At##8[m]), "v"(sc1));   \
        else { _Pragma("unroll") for (int k = 0; k < 2; ++k) acc[ai][bj][m][n] = __builtin_amdgcn_mfma_f32_16x16x32_bf16(Bt[n][k], At[m][k], acc[ai][bj][m][n], 0, 0, 0); } } __builtin_amdgcn_s_setprio(0); } while (0)
#define PG8_WAIT_V(n) asm volatile("s_waitcnt vmcnt(" #n ")" ::: "memory")
#define PG8_WAIT_L(n) asm volatile("s_waitcnt lgkmcnt(" #n ")" ::: "memory")
#define PG8_BAR __builtin_amdgcn_s_barrier()
#define PG8_SCHED __builtin_amdgcn_sched_barrier(0)
    Unit cur, nxt; int ui = 0;
    if (!S.next(0, cur)) return;
    f32x4 acc[2][2][4][2];
#pragma unroll
    for (int a = 0; a < 2; ++a)
#pragma unroll
        for (int b = 0; b < 2; ++b)
#pragma unroll
            for (int m = 0; m < 4; ++m)
#pragma unroll
                for (int n = 0; n < 2; ++n) acc[a][b][m][n] = (f32x4){0.f, 0.f, 0.f, 0.f};
    bf16x8 At[4][2], B0[2][2], B1[2][2];
    int sc1 = 0x7F7F7F7F; asm volatile("" : "+v"(sc1));
    v8i32 At8[4], B08[2], B18[2];
    (void)At; (void)B0; (void)B1; (void)At8; (void)B08; (void)B18; (void)sc1;
    unsigned cA0[2], cA1[2], nA0[2], nA1[2];
    S.a_offs(cur, RA, CA, rowB, cA0, cA1);
    const char* cB = S.b_ptr(cur);
    PG8_STAGE_B(PG8_SB(0, 0), cB); PG8_STAGE_B(PG8_SB(0, 1), cB + hstep); PG8_STAGE_A(PG8_SA(0, 0), cA0, 0); PG8_STAGE_A(PG8_SA(0, 1), cA1, 0);
    if (wr == 1) PG8_BAR;
    PG8_WAIT_V(2); PG8_BAR;
    PG8_STAGE_B(PG8_SB(1, 0), cB + kstep); PG8_STAGE_A(PG8_SA(1, 0), cA0, kstep); PG8_STAGE_B(PG8_SB(1, 1), cB + hstep + kstep);
    PG8_WAIT_V(6); PG8_BAR;
    for (;;) {
        const bool has_next = S.next(ui + 1, nxt);
        const char* nB = cB;
        if (has_next) { S.a_offs(nxt, RA, CA, rowB, nA0, nA1); nB = S.b_ptr(nxt); }
        else { nA0[0] = cA0[0]; nA0[1] = cA0[1]; nA1[0] = cA1[0]; nA1[1] = cA1[1]; }
#pragma nounroll
        for (int t = 0; t < nt; t += 2) {
            const bool last = (t == nt - 2);
            const unsigned k1 = (unsigned)(t + 1) * (unsigned)kstep;
            unsigned o20[2], o21[2];
            o20[0] = last ? nA0[0] : cA0[0]; o20[1] = last ? nA0[1] : cA0[1]; o21[0] = last ? nA1[0] : cA1[0]; o21[1] = last ? nA1[1] : cA1[1];
            const unsigned k2 = last ? 0u : (unsigned)(t + 2) * (unsigned)kstep, k3 = k2 + (unsigned)kstep;
            const char* b2 = last ? nB : cB + (size_t)(t + 2) * kstep; const char* b3 = b2 + kstep;
            PG8_LDB(B0, 0, 0); PG8_LDB(B1, 0, 1); PG8_SCHED; PG8_LDA(At, 0, 0); PG8_STAGE_A(PG8_SA(1, 1), cA1, k1);
            PG8_WAIT_V(8); PG8_WAIT_L(0); PG8_BAR; PG8_MMA(0, 0, At, B0); PG8_MMA(0, 1, At, B1); PG8_BAR; PG8_SCHED;
            PG8_LDA(At, 0, 1); PG8_STAGE_B(PG8_SB(0, 0), b2); PG8_STAGE_B(PG8_SB(0, 1), b2 + hstep); PG8_STAGE_A(PG8_SA(0, 0), o20, k2);
            PG8_WAIT_V(8); PG8_WAIT_L(0); PG8_BAR; PG8_MMA(1, 0, At, B0); PG8_MMA(1, 1, At, B1); PG8_BAR; PG8_SCHED;
            PG8_LDB(B0, 1, 0); PG8_LDB(B1, 1, 1); PG8_SCHED; PG8_LDA(At, 1, 0); PG8_STAGE_A(PG8_SA(0, 1), o21, k2);
            PG8_WAIT_V(8); PG8_WAIT_L(0); PG8_BAR; PG8_MMA(0, 0, At, B0); PG8_MMA(0, 1, At, B1); PG8_BAR; PG8_SCHED;
            PG8_LDA(At, 1, 1); PG8_STAGE_B(PG8_SB(1, 0), b3); PG8_STAGE_B(PG8_SB(1, 1), b3 + hstep); PG8_STAGE_A(PG8_SA(1, 0), o20, k3);
            PG8_WAIT_V(8); PG8_WAIT_L(0); PG8_BAR; PG8_MMA(1, 0, At, B0); PG8_MMA(1, 1, At, B1); PG8_BAR; PG8_SCHED;
        }
        if (wr == 0) PG8_BAR;
        if constexpr (FP8) asm volatile("s_nop 15\n\ts_nop 15" ::: "memory");
        E(acc, cur, wr, wc, fr, fq);
        if (!has_next) break;
#pragma unroll
        for (int a = 0; a < 2; ++a)
#pragma unroll
            for (int b = 0; b < 2; ++b)
#pragma unroll
                for (int m = 0; m < 4; ++m)
#pragma unroll
                    for (int n = 0; n < 2; ++n) acc[a][b][m][n] = (f32x4){0.f, 0.f, 0.f, 0.f};
        cur = nxt; cB = nB; cA0[0] = nA0[0]; cA0[1] = nA0[1]; cA1[0] = nA1[0]; cA1[1] = nA1[1]; ++ui;
        if (wr == 1) PG8_BAR;
    }
    PG8_WAIT_V(0);
    PG8_BAR;
#undef PG8_SA
#undef PG8_SB
#undef PG8_STAGE_A
#undef PG8_STAGE_B
#undef PG8_LDA
#undef PG8_LDB
#undef PG8_MMA
#undef PG8_WAIT_V
#undef PG8_WAIT_L
#undef PG8_BAR
#undef PG8_SCHED
}

struct DenseSched {
    int nM, nN, nwg, G, c; const char* Bt; int K; bool skip_ctx;
    __device__ __forceinline__ void init(int M_, int N_, int K_, int G_, int c_, const void* Bt_, bool skip, int esz = 2) { nM = M_ / BM; nN = N_ / BM; nwg = nM * nN; G = G_; c = c_; Bt = (const char*)Bt_; K = esz * K_  ; skip_ctx = skip; if (skip) { nM = nM / 17 * 16; nwg = nM * nN; } }
    __device__ __forceinline__ bool next(int i, Unit& u) const {
        const long Lx = (long)i * G + c; if (Lx >= nwg) return false;
        int wgid = (int)Lx; { const int q = nwg / 8, r = nwg % 8, xcd = wgid % 8, off = wgid / 8; wgid = (xcd < r ? xcd * (q + 1) : r * (q + 1) + (xcd - r) * q) + off; }
        const int nig = 8 * nN, gid = wgid / nig, fm = gid * 8, gsz = (nM - fm) < 8 ? (nM - fm) : 8;
        int pm = fm + ((wgid % nig) % gsz); u.pn = (wgid % nig) / gsz;
        if (skip_ctx) pm = pm + pm / 16 + 1;
        u.pm = pm; u.e = 0; u.rt = 0; return true;
    }
    __device__ __forceinline__ void a_offs(const Unit& u, const int (&RA)[2], const int (&CA)[2], int rowB, unsigned (&o0)[2], unsigned (&o1)[2]) const {
#pragma unroll
        for (int i = 0; i < 2; ++i) { o0[i] = (unsigned)((u.pm * BM + RA[i]) * rowB + CA[i] * 2); o1[i] = (unsigned)((u.pm * BM + HALF + RA[i]) * rowB + CA[i] * 2); }
    }
    __device__ __forceinline__ const char* b_ptr(const Unit& u) const { return Bt + (size_t)u.pn * BM * K; }
};
struct OneSched {
    int pm, pn; const char* Bt; int K  ;
    __device__ __forceinline__ bool next(int i, Unit& u) const { if (i > 0) return false; u.pm = pm; u.pn = pn; u.e = 0; u.rt = 0; return true; }
    __device__ __forceinline__ void a_offs(const Unit& u, const int (&RA)[2], const int (&CA)[2], int rowB, unsigned (&o0)[2], unsigned (&o1)[2]) const {
#pragma unroll
        for (int i = 0; i < 2; ++i) { o0[i] = (unsigned)((u.pm * BM + RA[i]) * rowB + CA[i] * 2); o1[i] = (unsigned)((u.pm * BM + HALF + RA[i]) * rowB + CA[i] * 2); }
    }
    __device__ __forceinline__ const char* b_ptr(const Unit& u) const { return Bt + (size_t)u.pn * BM * K; }
};
template <bool GATHER>
struct MoeSched {
    int G, c, nN, K  ; const char* Bt; size_t estride; const LAS int* tp; const LAS int* cnt; const int* tok;
    __device__ __forceinline__ bool next(int i, Unit& u) const {
        const int Lx = i * G + c; const int ntile = tp[16];
        if (Lx >= ntile * nN) return false;
        const int pm = Lx / nN; u.pn = Lx - pm * nN; u.pm = pm;
        int e = 0;
#pragma unroll
        for (int j = 1; j < 16; ++j) e += (pm >= tp[j]) ? 1 : 0;
        u.e = e; u.rt = pm - tp[e]; return true;
    }
    __device__ __forceinline__ void a_offs(const Unit& u, const int (&RA)[2], const int (&CA)[2], int rowB, unsigned (&o0)[2], unsigned (&o1)[2]) const {
        if (GATHER) {
            const int n = cnt[u.e];
#pragma unroll
            for (int i = 0; i < 2; ++i) {
                const int p0 = u.rt * BM + RA[i], p1 = p0 + HALF;
                const int t0 = p0 < n ? tok[(size_t)u.e * CAP + p0] : 0, t1 = p1 < n ? tok[(size_t)u.e * CAP + p1] : 0;
                o0[i] = (unsigned)((t0 >> 1) * rowB + CA[i] * 2); o1[i] = (unsigned)((t1 >> 1) * rowB + CA[i] * 2);
            }
        } else {
#pragma unroll
            for (int i = 0; i < 2; ++i) { o0[i] = (unsigned)((u.pm * BM + RA[i]) * rowB + CA[i] * 2); o1[i] = (unsigned)((u.pm * BM + HALF + RA[i]) * rowB + CA[i] * 2); }
        }
    }
    __device__ __forceinline__ const char* b_ptr(const Unit& u) const { return Bt + (size_t)u.e * estride + (size_t)u.pn * BM * K; }
};

constexpr float WSCALE = 32.0f, WINV = 1.0f / 32.0f;
#define EPI_ARGS const f32x4 (&acc)[2][2][4][2], const Unit& u, int wr, int wc, int fr, int fq
__device__ __forceinline__ u32x4 pack8(f32x4 a, f32x4 b) { u32x4 w; w.x = cvt_pk_bf16(a[0], a[1]); w.y = cvt_pk_bf16(a[2], a[3]); w.z = cvt_pk_bf16(b[0], b[1]); w.w = cvt_pk_bf16(b[2], b[3]); return w; }
__device__ __forceinline__ unsigned char* qk8_ptr(unsigned char* QK8, int pm, int lr, int pn, int wc, int fq, int bj) {
    if (pn < 2) return QK8 + (size_t)(pm * BM + lr) * 1024 + pn * BM + wc * 32 + 8 * fq + bj * HALF;
    asm volatile("" : "+v"(lr));
    const int b = pm / 17, tb = pm - b * 17, h = (pn - 2) * 2 + bj;
    return QK8 + K8T_OFF + ((size_t)((b * 4 + h) * (LT / 64) + tb * 4 + (lr >> 6)) * 64 + (lr & 63)) * 128 + wc * 32 + 8 * fq;
}
struct EpiG1 {
    bf16_t* P; const float* ropec; const float* ropes; unsigned char* QK8;
    __device__ __forceinline__ void operator()(EPI_ARGS) const {
        const int pn = u.pn, tb = u.pm % 17;
        const bool rope = (tb != 0) && (pn < 4 || pn == 7 || pn == 8);
        const bool qk8 = pn < 4;
        const float sc = WINV * ((pn == 8) ? 0.125f : (pn < 2 ? 0.125f * 1.4426950408889634f * 4.0f : (pn < 4 ? 0.25f : 1.0f)));
        const int axis = wc & 1;
        if (rope) {
#pragma unroll
            for (int ai = 0; ai < 2; ++ai)
#pragma unroll
                for (int m = 0; m < 4; ++m) {
                    const int lr = ai * HALF + wr * 64 + m * 16 + fr;
                    const int gr = (tb - 1) * 4 + (lr >> 6), gc = lr & 63; const int pos = axis ? gc : gr;
                    f32x4 cs0 = *(const f32x4*)(ropec + pos * 16 + 4 * fq), sn0 = *(const f32x4*)(ropes + pos * 16 + 4 * fq);
                    cs0 = cs0 * sc; sn0 = sn0 * sc;
                    bf16_t* rowp = P + (size_t)(u.pm * BM + lr) * INW + pn * BM + wc * 32 + 8 * fq;
#pragma unroll
                    for (int bj = 0; bj < 2; ++bj) {
                        const f32x4 v0 = acc[ai][bj][m][0], v1 = acc[ai][bj][m][1];
                        f32x4 r0, r1;
                        r0[0] = v0[0] * cs0[0] - v0[1] * sn0[0]; r0[1] = v0[1] * cs0[0] + v0[0] * sn0[0];
                        r0[2] = v0[2] * cs0[1] - v0[3] * sn0[1]; r0[3] = v0[3] * cs0[1] + v0[2] * sn0[1];
                        r1[0] = v1[0] * cs0[2] - v1[1] * sn0[2]; r1[1] = v1[1] * cs0[2] + v1[0] * sn0[2];
                        r1[2] = v1[2] * cs0[3] - v1[3] * sn0[3]; r1[3] = v1[3] * cs0[3] + v1[2] * sn0[3];
                        if (qk8) { u32x2 w8; w8.x = pk4_fp8(r0[0], r0[1], r0[2], r0[3]); w8.y = pk4_fp8(r1[0], r1[1], r1[2], r1[3]); *(u32x2*)qk8_ptr(QK8, u.pm, lr, pn, wc, fq, bj) = w8; }
                        else *(u32x4*)(rowp + bj * HALF) = pack8(r0, r1);
                    }
                    if (m & 1) asm volatile("" ::: "memory");
                }
        } else {
#pragma unroll
            for (int ai = 0; ai < 2; ++ai)
#pragma unroll
                for (int m = 0; m < 4; ++m) {
                    const int lr = ai * HALF + wr * 64 + m * 16 + fr;
                    bf16_t* rowp = P + (size_t)(u.pm * BM + lr) * INW + pn * BM + wc * 32 + 8 * fq;
#pragma unroll
                    for (int bj = 0; bj < 2; ++bj) { const f32x4 a0 = acc[ai][bj][m][0] * sc, a1 = acc[ai][bj][m][1] * sc;
                        if (qk8) { u32x2 w8; w8.x = pk4_fp8(a0[0], a0[1], a0[2], a0[3]); w8.y = pk4_fp8(a1[0], a1[1], a1[2], a1[3]); *(u32x2*)qk8_ptr(QK8, u.pm, lr, pn, wc, fq, bj) = w8; }
                        else *(u32x4*)(rowp + bj * HALF) = pack8(a0, a1); }
                }
        }
    }
};
struct EpiG2 {
    const float* xin_lat; const float* xin_ctx; bf16_t* XB; const float* modl; bool first;
    __device__ __forceinline__ void operator()(EPI_ARGS) const {
        const int b = u.pm / 17, tb = u.pm - b * 17;
        const bool isctx = (tb == 0);
        const float* g = modl + (size_t)(isctx ? 8 : b) * 6144 + 2048;
        const int col0 = u.pn * BM + wc * 32 + 8 * fq;
        f32x4 gv[2][2];
#pragma unroll
        for (int bj = 0; bj < 2; ++bj) { gv[bj][0] = *(const f32x4*)(g + col0 + bj * HALF); gv[bj][1] = *(const f32x4*)(g + col0 + bj * HALF + 4); }
        if (first) {
            const size_t rbase = isctx ? (size_t)b * LC : (size_t)b * L + (size_t)(tb - 1) * BM;
            const float* src = isctx ? xin_ctx : xin_lat;
#pragma unroll
            for (int ai = 0; ai < 2; ++ai) {
                f32x4 o[4][2][2];
#pragma unroll
                for (int m = 0; m < 4; ++m) { const size_t off = (rbase + ai * HALF + wr * 64 + m * 16 + fr) * D + col0;
#pragma unroll
                    for (int bj = 0; bj < 2; ++bj) { o[m][bj][0] = *(const f32x4*)(src + off + bj * HALF); o[m][bj][1] = *(const f32x4*)(src + off + bj * HALF + 4); } }
                asm volatile("" ::: "memory");
#pragma unroll
                for (int m = 0; m < 4; ++m) { bf16_t* dp = XB + (size_t)(u.pm * BM + ai * HALF + wr * 64 + m * 16 + fr) * D + col0;
#pragma unroll
                    for (int bj = 0; bj < 2; ++bj) *(u32x4*)(dp + bj * HALF) = pack8(o[m][bj][0] + gv[bj][0] * acc[ai][bj][m][0], o[m][bj][1] + gv[bj][1] * acc[ai][bj][m][1]); }
                asm volatile("" ::: "memory");
            }
        } else {
#pragma unroll
            for (int ai = 0; ai < 2; ++ai) {
                u32x4 o[4][2];
#pragma unroll
                for (int m = 0; m < 4; ++m) { const bf16_t* sp = XB + (size_t)(u.pm * BM + ai * HALF + wr * 64 + m * 16 + fr) * D + col0;
#pragma unroll
                    for (int bj = 0; bj < 2; ++bj) o[m][bj] = *(const u32x4*)(sp + bj * HALF); }
                asm volatile("" ::: "memory");
#pragma unroll
                for (int m = 0; m < 4; ++m) { bf16_t* dp = XB + (size_t)(u.pm * BM + ai * HALF + wr * 64 + m * 16 + fr) * D + col0;
#pragma unroll
                    for (int bj = 0; bj < 2; ++bj) { const u32x4 w = o[m][bj];
                        const f32x4 x0 = bf4_to_f4((u32x2){w.x, w.y}), x1 = bf4_to_f4((u32x2){w.z, w.w});
                        *(u32x4*)(dp + bj * HALF) = pack8(x0 + gv[bj][0] * acc[ai][bj][m][0], x1 + gv[bj][1] * acc[ai][bj][m][1]); } }
                asm volatile("" ::: "memory");
            }
        }
    }
};
constexpr float YSCALE = 16.0f, YINV = 1.0f / 16.0f;
struct EpiE1 {
    unsigned char* ACT;
    __device__ __forceinline__ void operator()(EPI_ARGS) const {
        const int col0 = 8 * ((u.pn * 4 + wc) * 4 + fq);
#pragma unroll
        for (int ai = 0; ai < 2; ++ai)
#pragma unroll
            for (int m = 0; m < 4; ++m) {
                const int lr = ai * HALF + wr * 64 + m * 16 + fr;
                u32x2 w;
                { const f32x4 g = acc[ai][0][m][0] * WINV, up = acc[ai][0][m][1] * WINV; w.x = pk4_fp8(silu_f(g[0]) * up[0], silu_f(g[1]) * up[1], silu_f(g[2]) * up[2], silu_f(g[3]) * up[3]); }
                { const f32x4 g = acc[ai][1][m][0] * WINV, up = acc[ai][1][m][1] * WINV; w.y = pk4_fp8(silu_f(g[0]) * up[0], silu_f(g[1]) * up[1], silu_f(g[2]) * up[2], silu_f(g[3]) * up[3]); }
                *(u32x2*)(ACT + (size_t)(u.pm * BM + lr) * DE + col0) = w;
            }
    }
};
struct EpiE2 {
    unsigned char* Y2; const int* tok; const float* gate; const LAS int* cnt;
    __device__ __forceinline__ void operator()(EPI_ARGS) const {
        const int n = cnt[u.e];
        const int col0 = u.pn * BM + wc * 32 + 8 * fq;
        int pr[8]; float gt[8];
#pragma unroll
        for (int q = 0; q < 8; ++q) { const int pos = u.rt * BM + (q >> 2) * HALF + wr * 64 + (q & 3) * 16 + fr; pr[q] = pos < n ? tok[(size_t)u.e * CAP + pos] : -1; }
#pragma unroll
        for (int q = 0; q < 8; ++q) gt[q] = pr[q] >= 0 ? gate[pr[q]] * (WINV * YSCALE) : 0.f;
#pragma unroll
        for (int q = 0; q < 8; ++q) {
            if (pr[q] >= 0) {
                unsigned char* rowp = Y2 + (size_t)pr[q] * D + col0;
#pragma unroll
                for (int bj = 0; bj < 2; ++bj) { const f32x4 a0 = acc[q >> 2][bj][q & 3][0] * gt[q], a1 = acc[q >> 2][bj][q & 3][1] * gt[q];
                    u32x2 w; w.x = pk4_fp8(a0[0], a0[1], a0[2], a0[3]); w.y = pk4_fp8(a1[0], a1[1], a1[2], a1[3]); *(u32x2*)(rowp + bj * HALF) = w; }
            }
        }
    }
};
}

namespace att {
constexpr int NW = 8, QBLK = 32, KVBLK = 64;
constexpr float SCALE = 0.125f;
constexpr float THR = 8.f;
constexpr int NBUF = 3;
constexpr size_t SHM_V = KVBLK * 128 * 2, SHM_K = KVBLK * 128 * 2, SHM_ATTN = NBUF * SHM_V + NBUF * SHM_K + NW * 64 * 4;
#define KSWZ(row, colB) ((row) * 256 + ((colB) ^ (((row) & 7) << 4)))
#define SBAR() __builtin_amdgcn_sched_barrier(0)
__device__ __forceinline__ int crow(int r, int hi) { return (r & 3) + 8 * (r >> 2) + 4 * hi; }
__device__ __forceinline__ unsigned cvtpk(float lo, float hi) { unsigned r; asm volatile("v_cvt_pk_bf16_f32 %0, %1, %2" : "=v"(r) : "v"(lo), "v"(hi)); return r; }
__device__ __forceinline__ bf16x8 ld8(const bf16_t* p) { return *reinterpret_cast<const bf16x8*>(p); }

constexpr float C2 = SCALE * 1.4426950408889634f;
constexpr float THR2 = THR * 1.4426950408889634f;
__device__ __forceinline__ void partialSM(f32x16& p0, f32x16& p1, float& mhat, f32x16& negm, float& alpha) {
  float pmax = p0[0];
#pragma unroll
  for (int r = 1; r < 16; ++r) pmax = fmaxf(pmax, p0[r]);
#pragma unroll
  for (int r = 0; r < 16; ++r) pmax = fmaxf(pmax, p1[r]);
  { auto rr = __builtin_amdgcn_permlane32_swap(__float_as_uint(pmax), __float_as_uint(pmax), false, false);
    pmax = fmaxf(__uint_as_float(rr[0]), __uint_as_float(rr[1])); }
  if (__builtin_expect(__all(pmax <= THR2), 1)) { alpha = 1.f; }
  else { const float dl = fmaxf(pmax, 0.f); mhat += dl;
#pragma unroll
    for (int r = 0; r < 16; ++r) { p0[r] -= dl; p1[r] -= dl; }
#pragma unroll
    for (int r = 0; r < 16; ++r) negm[r] = -mhat;
    alpha = __builtin_amdgcn_exp2f(-dl); }
#pragma unroll
  for (int r = 0; r < 16; ++r) p0[r] = __builtin_amdgcn_exp2f(p0[r]);
}
#define PK4(P, BASE, OUT) do { unsigned a0 = cvtpk(P[BASE + 0], P[BASE + 1]), a1 = cvtpk(P[BASE + 2], P[BASE + 3]);   \
    unsigned b0 = cvtpk(P[BASE + 4], P[BASE + 5]), b1 = cvtpk(P[BASE + 6], P[BASE + 7]);                              \
    auto r0 = __builtin_amdgcn_permlane32_swap(a0, b0, false, false); auto r1 = __builtin_amdgcn_permlane32_swap(a1, b1, false, false); \
    u32x4 w = {r0[0], r1[0], r0[1], r1[1]}; OUT = *reinterpret_cast<bf16x8*>(&w); } while (0)
__device__ __forceinline__ void finishSM(f32x16& p0, f32x16& p1, float alpha, float& l_reg, bf16x8& pa0, bf16x8& pa1, bf16x8& pa2, bf16x8& pa3) {
#pragma unroll
  for (int r = 0; r < 16; ++r) p1[r] = __builtin_amdgcn_exp2f(p1[r]);
  float ps = 0;
#pragma unroll
  for (int r = 0; r < 16; ++r) ps += p0[r];
#pragma unroll
  for (int r = 0; r < 16; ++r) ps += p1[r];
  { auto rr = __builtin_amdgcn_permlane32_swap(__float_as_uint(ps), __float_as_uint(ps), false, false);
    ps = __uint_as_float(rr[0]) + __uint_as_float(rr[1]); }
  l_reg = l_reg * alpha + ps;
  PK4(p0, 0, pa0); PK4(p0, 8, pa1); PK4(p1, 0, pa2); PK4(p1, 8, pa3);
}
__device__ __forceinline__ void qkt(f32x16& p0, f32x16& p1, const bf16_t* Ks, const bf16x8* qr, int r32, int hi, int dbase, const f32x16& negm) {
#pragma unroll
  for (int d0 = 0; d0 < 4; ++d0) { int cb = (dbase + d0 * 16 + hi * 8) * 2;
    bf16x8 b0 = *reinterpret_cast<const bf16x8*>((const char*)Ks + KSWZ(r32, cb));
    bf16x8 b1 = *reinterpret_cast<const bf16x8*>((const char*)Ks + KSWZ(32 + r32, cb));
    if (d0 == 0) { p0 = __builtin_amdgcn_mfma_f32_32x32x16_bf16(b0, qr[0], negm, 0, 0, 0); p1 = __builtin_amdgcn_mfma_f32_32x32x16_bf16(b1, qr[0], negm, 0, 0, 0); }
    else { p0 = __builtin_amdgcn_mfma_f32_32x32x16_bf16(b0, qr[d0], p0, 0, 0, 0); p1 = __builtin_amdgcn_mfma_f32_32x32x16_bf16(b1, qr[d0], p1, 0, 0, 0); } }
}
template <int CPT> __device__ __forceinline__ int v_st(int k, int c) { const int kk = (k & ~0xC) | ((k & 4) << 1) | ((k & 8) >> 1); return ((kk >> 3) * CPT + (c >> 5)) * 512 + ((kk & 7) * 32 + (c & 31)) * 2; }
__device__ __forceinline__ int v_rd_base(int lane) { return ((lane & 3) << 3) | (((lane >> 2) & 3) << 6) | (((lane >> 4) & 1) << 5) | (((lane >> 5) & 1) << 8); }
template <int CPT> constexpr int v_rd_off(int d0, int ks, int half) { return d0 * 512 + ks * (CPT * 1024) + half * (CPT * 512); }
template <int OFF> __device__ __forceinline__ s16x4 tr_read(int vb) {
  s16x4 r; asm volatile("ds_read_b64_tr_b16 %0, %1 offset:%2" : "=&v"(r) : "v"(vb), "i"(OFF) : "memory"); return r;
}
template <int CPT, int D0> __device__ __forceinline__ void pv_one(f32x16& od, int vb, bf16x8 pa0, bf16x8 pa1, bf16x8 pa2, bf16x8 pa3) {
  const s16x4 l0 = tr_read<v_rd_off<CPT>(D0, 0, 0)>(vb), h0 = tr_read<v_rd_off<CPT>(D0, 0, 1)>(vb), l1 = tr_read<v_rd_off<CPT>(D0, 1, 0)>(vb), h1 = tr_read<v_rd_off<CPT>(D0, 1, 1)>(vb);
  const s16x4 l2 = tr_read<v_rd_off<CPT>(D0, 2, 0)>(vb), h2 = tr_read<v_rd_off<CPT>(D0, 2, 1)>(vb), l3 = tr_read<v_rd_off<CPT>(D0, 3, 0)>(vb), h3 = tr_read<v_rd_off<CPT>(D0, 3, 1)>(vb);
  asm volatile("s_waitcnt lgkmcnt(0)" ::: "memory"); SBAR();
#define PK(L_, H_) (bf16x8){L_[0], L_[1], L_[2], L_[3], H_[0], H_[1], H_[2], H_[3]}
  od = __builtin_amdgcn_mfma_f32_32x32x16_bf16(pa0, PK(l0, h0), od, 0, 0, 0);
  od = __builtin_amdgcn_mfma_f32_32x32x16_bf16(pa1, PK(l1, h1), od, 0, 0, 0);
  od = __builtin_amdgcn_mfma_f32_32x32x16_bf16(pa2, PK(l2, h2), od, 0, 0, 0);
  od = __builtin_amdgcn_mfma_f32_32x32x16_bf16(pa3, PK(l3, h3), od, 0, 0, 0);
#undef PK
}
__device__ __forceinline__ void pv4(f32x16* o, int vb, bf16x8 pa0, bf16x8 pa1, bf16x8 pa2, bf16x8 pa3) {
  pv_one<4, 0>(o[0], vb, pa0, pa1, pa2, pa3); pv_one<4, 1>(o[1], vb, pa0, pa1, pa2, pa3); pv_one<4, 2>(o[2], vb, pa0, pa1, pa2, pa3); pv_one<4, 3>(o[3], vb, pa0, pa1, pa2, pa3);
}
__device__ __forceinline__ void pv2(f32x16* o, int vb, bf16x8 pa0, bf16x8 pa1, bf16x8 pa2, bf16x8 pa3) {
  pv_one<2, 0>(o[0], vb, pa0, pa1, pa2, pa3); pv_one<2, 1>(o[1], vb, pa0, pa1, pa2, pa3);
}

__device__ __forceinline__ void attn_unit(const bf16_t* __restrict__ P, int qrow0, int krow0, int seq, int h, float lam, const float* __restrict__ nw, float oscale, bf16_t* __restrict__ MIX, char* lds, const int wave0) {
  const int tid = opaque_tid(wave0), wid = tid >> 6, lane = tid & 63, r32 = lane & 31, hi = lane >> 5;
  const int map = wid >> 2, wq = wid & 3;
  bf16_t* V_lds = (bf16_t*)lds; bf16_t* K_lds = (bf16_t*)(lds + NBUF * SHM_V);
  float* ws = (float*)(lds + NBUF * SHM_V + NBUF * SHM_K) + wid * 64; float* li_l = ws; float* al_l = ws + 32;
  float m_reg = 0.f  , l_reg = 0; f32x16 o[4] = {}; bf16x8 qr[4]; f32x16 negm = {};
  const bf16_t* Qw = P + (size_t)(qrow0 + wq * QBLK + r32) * INW + OFF_DQ + h * 128 + map * 64 + hi * 8;
#pragma unroll
  for (int d0 = 0; d0 < 4; ++d0) { const bf16x8 raw = ld8(Qw + d0 * 16); u32x4 w;
#pragma unroll
    for (int z = 0; z < 4; ++z) w[z] = cvtpk(bf2f((bf16_t)raw[2 * z]) * C2, bf2f((bf16_t)raw[2 * z + 1]) * C2);
    qr[d0] = *reinterpret_cast<bf16x8*>(&w); }
  const bf16_t* Kh = P + (size_t)krow0 * INW + OFF_DK + h * 128;
  const bf16_t* Vh = P + (size_t)krow0 * INW + OFF_DV + h * 128;
  const int sr = tid >> 4, sc = (tid & 15) * 8, vst0 = v_st<4>(sr, sc), vst1 = v_st<4>(32 + sr, sc);
  const int vb0 = (int)(uintptr_t)V_lds + v_rd_base(lane);
  const int dbase = map * 64;
  struct { bf16x8 vs0, vs1, ks0, ks1; } sr_[2];
#define SLOAD(i, k0) do { sr_[i].vs0 = ld8(&Vh[(size_t)((k0) + sr) * INW + sc]); sr_[i].vs1 = ld8(&Vh[(size_t)((k0) + 32 + sr) * INW + sc]); \
    sr_[i].ks0 = ld8(&Kh[(size_t)((k0) + sr) * INW + sc]); sr_[i].ks1 = ld8(&Kh[(size_t)((k0) + 32 + sr) * INW + sc]); } while (0)
#define SWRITE(b, i) do { *(bf16x8*)((char*)V_lds + (b) * SHM_V + vst0) = sr_[i].vs0;          \
    *(bf16x8*)((char*)V_lds + (b) * SHM_V + vst1) = sr_[i].vs1; int kc = sc * 2;               \
    *(bf16x8*)((char*)K_lds + (b) * SHM_K + KSWZ(sr, kc)) = sr_[i].ks0;                       \
    *(bf16x8*)((char*)K_lds + (b) * SHM_K + KSWZ(32 + sr, kc)) = sr_[i].ks1; } while (0)
#define SWAIT() asm volatile("s_waitcnt vmcnt(4)" ::: "memory")
#define RESC(a) do { if (__any((a) < 1.f)) { if (hi == 0) al_l[r32] = (a); asm volatile("s_waitcnt lgkmcnt(0)" ::: "memory"); \
    _Pragma("unroll") for (int d = 0; d < 4; ++d) _Pragma("unroll") for (int r = 0; r < 16; ++r) o[d][r] *= al_l[crow(r, hi)]; } } while (0)
  f32x16 pA0, pA1, pB0, pB1; float alA, alB; bf16x8 pa0, pa1, pa2, pa3; const int NT = seq / KVBLK;
  constexpr int SE = 0, SO = 1;
  int bprev = 0, bcur = 1, bnext = 2;
#define KBUF(b) ((bf16_t*)((char*)K_lds + (b) * (int)SHM_K))
#define VBUF(b) (vb0 + (b) * (int)SHM_V)
#define ROT3() do { const int t_ = bprev; bprev = bcur; bcur = bnext; bnext = t_; } while (0)
  SLOAD(SE, 0); asm volatile("s_waitcnt vmcnt(0)" ::: "memory"); SWRITE(0, SE);
  SLOAD(SO, KVBLK); SLOAD(SE, 2 * KVBLK);
  __syncthreads();
  qkt(pA0, pA1, KBUF(0), qr, r32, hi, dbase, negm); partialSM(pA0, pA1, m_reg, negm, alA);
  SWAIT(); SWRITE(1, SO); __syncthreads();
  for (int j = 1; j + 1 < NT; j += 2) {
    SBAR(); qkt(pB0, pB1, KBUF(bcur), qr, r32, hi, dbase, negm);
    finishSM(pA0, pA1, alA, l_reg, pa0, pa1, pa2, pa3); SBAR();
    SLOAD(SO, (j + 2) * KVBLK); SBAR();
    pv4(o, VBUF(bprev), pa0, pa1, pa2, pa3); partialSM(pB0, pB1, m_reg, negm, alB);
    SWAIT(); SWRITE(bnext, SE);
    RESC(alB); __syncthreads(); ROT3();
    SBAR(); qkt(pA0, pA1, KBUF(bcur), qr, r32, hi, dbase, negm);
    finishSM(pB0, pB1, alB, l_reg, pa0, pa1, pa2, pa3); SBAR();
    if (j + 3 < NT) SLOAD(SE, (j + 3) * KVBLK); SBAR();
    pv4(o, VBUF(bprev), pa0, pa1, pa2, pa3); partialSM(pA0, pA1, m_reg, negm, alA);
    if (j + 3 < NT) SWAIT(); else asm volatile("s_waitcnt vmcnt(0)" ::: "memory");
    SWRITE(bnext, SO);
    RESC(alA); __syncthreads(); ROT3();
  }
  SBAR(); qkt(pB0, pB1, KBUF(bcur), qr, r32, hi, dbase, negm);
  finishSM(pA0, pA1, alA, l_reg, pa0, pa1, pa2, pa3); SBAR();
  pv4(o, VBUF(bprev), pa0, pa1, pa2, pa3); partialSM(pB0, pB1, m_reg, negm, alB);
  RESC(alB);
  finishSM(pB0, pB1, alB, l_reg, pa0, pa1, pa2, pa3); SBAR();
  pv4(o, VBUF(bcur), pa0, pa1, pa2, pa3);
#undef KBUF
#undef VBUF
#undef ROT3
  { const int tid_e = opaque_tid(wave0), lane_e = tid_e & 63; const int lane = lane_e, r32 = lane_e & 31, hi = lane_e >> 5, wid = tid_e >> 6, map = wid >> 2, wq = wid & 3; (void)map; (void)wq;
  if (hi == 0) li_l[r32] = l_reg; asm volatile("s_waitcnt lgkmcnt(0)" ::: "memory");
  float rli[16];
#pragma unroll
  for (int r = 0; r < 16; ++r) rli[r] = __builtin_amdgcn_rcpf(li_l[crow(r, hi)]);
  __syncthreads();
  float* stash = (float*)lds + wq * 4096;
  if (map == 1) {
#pragma unroll
    for (int d0 = 0; d0 < 4; ++d0)
#pragma unroll
      for (int r = 0; r < 16; ++r) stash[(d0 * 16 + r) * 64 + lane] = lam * o[d0][r] * rli[r];
  }
  __syncthreads();
  if (map == 0) {
    float rs[16];
#pragma unroll
    for (int r = 0; r < 16; ++r) {
      float ss = 0.f;
#pragma unroll
      for (int d0 = 0; d0 < 4; ++d0) { const float a = o[d0][r] * rli[r] - stash[(d0 * 16 + r) * 64 + lane]; o[d0][r] = a; ss += a * a; }
      ss = half_sum32(ss, lane);
      rs[r] = oscale / sqrtf(ss * (1.0f / 128.0f) + EPS);
    }
    float nwv[4];
#pragma unroll
    for (int d0 = 0; d0 < 4; ++d0) nwv[d0] = nw[d0 * 32 + r32];
    bf16_t* Ow = MIX + (size_t)(qrow0 + wq * QBLK) * D + h * 128;
#pragma unroll
    for (int r = 0; r < 16; ++r) { const int orow = crow(r, hi);
#pragma unroll
      for (int d0 = 0; d0 < 4; ++d0) Ow[(size_t)orow * D + d0 * 32 + r32] = f2bf(o[d0][r] * rs[r] * nwv[d0]); }
  }
  }
  __syncthreads();
#undef SLOAD
#undef SWRITE
#undef SWAIT
#undef RESC
}

typedef int v8i __attribute__((ext_vector_type(8)));
typedef int v4i __attribute__((ext_vector_type(4)));
constexpr int DIST8 = 4, NB8 = DIST8 + 2, K8B = 8192, V8B = 8192 + 2048;
__device__ __forceinline__ v8i ldsrd32(const char* p0, const char* p1) { const v4i a = *(const v4i*)p0, b = *(const v4i*)p1; return __builtin_shufflevector(a, b, 0, 1, 2, 3, 4, 5, 6, 7); }
#define MFMA8_NEW(D_, A_, B_, C_, SC_, SCB_) asm volatile("v_mfma_scale_f32_32x32x64_f8f6f4 %0, %1, %2, %3, %4, %5 op_sel_hi:[0,0,0]" : "=&v"(D_) : "v"(A_), "v"(B_), "v"(C_), "v"(SC_), "v"(SCB_))
#define MFMA8_ACC(D_, A_, B_, SC_) asm volatile("v_mfma_scale_f32_32x32x64_f8f6f4 %0, %1, %2, %0, %3, %3 op_sel_hi:[0,0,0]" : "+v"(D_) : "v"(A_), "v"(B_), "v"(SC_))
constexpr float P8_U = 1.0f / 65536.0f;
constexpr float P8_ONE = 96.0f * P8_U;
constexpr float THR8 = 28.0f * P8_U;
__device__ __forceinline__ void partialSM8(f32x16& p0, f32x16& p1, float& mhat, f32x16& negm, float& alpha) {
  float pmax = p0[0];
#pragma unroll
  for (int r = 1; r < 16; ++r) pmax = fmaxf(pmax, p0[r]);
#pragma unroll
  for (int r = 0; r < 16; ++r) pmax = fmaxf(pmax, p1[r]);
  { auto rr = __builtin_amdgcn_permlane32_swap(__float_as_uint(pmax), __float_as_uint(pmax), false, false);
    pmax = fmaxf(__uint_as_float(rr[0]), __uint_as_float(rr[1])); }
  if (__builtin_expect(__all(pmax <= P8_ONE + THR8), 1)) { alpha = 1.f; }
  else { const float dl = fmaxf(pmax - P8_ONE, 0.f); mhat += dl;
#pragma unroll
    for (int r = 0; r < 16; ++r) { p0[r] -= dl; p1[r] -= dl; }
#pragma unroll
    for (int r = 0; r < 16; ++r) negm[r] -= dl;
    alpha = __builtin_amdgcn_exp2f(-0.125f * 65536.0f * dl); }
}
__device__ __forceinline__ float max16(const f32x16& p, float m) {
  asm("v_max3_f32 %0, %0, %1, %2\n\tv_max3_f32 %0, %0, %3, %4\n\tv_max3_f32 %0, %0, %5, %6\n\tv_max3_f32 %0, %0, %7, %8\n\tv_max3_f32 %0, %0, %9, %10\n\tv_max3_f32 %0, %0, %11, %12\n\tv_max3_f32 %0, %0, %13, %14\n\tv_max3_f32 %0, %0, %15, %16"
      : "+v"(m) : "v"(p[0]), "v"(p[1]), "v"(p[2]), "v"(p[3]), "v"(p[4]), "v"(p[5]), "v"(p[6]), "v"(p[7]), "v"(p[8]), "v"(p[9]), "v"(p[10]), "v"(p[11]), "v"(p[12]), "v"(p[13]), "v"(p[14]), "v"(p[15]));
  return m;
}
__device__ __forceinline__ void decideSM8(float pmax, f32x16& p0, f32x16& p1, f32x16& negm, float& alpha) {
  if (__builtin_expect(__all(pmax <= P8_ONE + THR8), 1)) { alpha = 1.f; }
  else {
    { auto rr = __builtin_amdgcn_permlane32_swap(__float_as_uint(pmax), __float_as_uint(pmax), false, false);
      const float a_ = __uint_as_float(rr[0]), b_ = __uint_as_float(rr[1]); asm("v_max_f32 %0, %1, %2" : "=v"(pmax) : "v"(a_), "v"(b_)); }
    const float dl = fmaxf(pmax - P8_ONE, 0.f);
#pragma unroll
    for (int r = 0; r < 16; ++r) { p0[r] -= dl; p1[r] -= dl; }
#pragma unroll
    for (int r = 0; r < 16; ++r) negm[r] -= dl;
    alpha = __builtin_amdgcn_exp2f(-0.125f * 65536.0f * dl); }
}
typedef unsigned short us2_t __attribute__((ext_vector_type(2)));
__device__ __forceinline__ unsigned pk4_u8(float a, float b, float c, float d) {
  const us2_t w0 = __builtin_amdgcn_cvt_pknorm_u16(a, b), w1 = __builtin_amdgcn_cvt_pknorm_u16(c, d);
  return __builtin_amdgcn_perm(__builtin_bit_cast(unsigned, w1), __builtin_bit_cast(unsigned, w0), 0x06040200u); }
__device__ __forceinline__ void finishSM8(f32x16& p0, f32x16& p1, v8i& pa) {
#pragma unroll
  for (int g = 0; g < 4; ++g) { pa[g] = (int)pk4_u8(p0[4 * g], p0[4 * g + 1], p0[4 * g + 2], p0[4 * g + 3]); pa[4 + g] = (int)pk4_u8(p1[4 * g], p1[4 * g + 1], p1[4 * g + 2], p1[4 * g + 3]); }
}
__device__ __forceinline__ void qkt8(f32x16& p0, f32x16& p1, const char* Kb, const v8i& q8, int r32, int hi, int map, const f32x16& negm, int sc1, int sc8) {
  const int c0 = 4 * map + 2 * hi;
  const int sw0 = (r32 >> 1) & 7;
  const char* ra = Kb + r32 * 128; const char* rb = Kb + (32 + r32) * 128;
  const v8i k0 = ldsrd32(ra + ((c0 ^ sw0) << 4), ra + (((c0 + 1) ^ sw0) << 4));
  const v8i k1 = ldsrd32(rb + ((c0 ^ sw0) << 4), rb + (((c0 + 1) ^ sw0) << 4));
  MFMA8_NEW(p0, k0, q8, negm, sc1, sc8);
  MFMA8_NEW(p1, k1, q8, negm, sc1, sc8);
  asm volatile("s_nop 15\n\ts_nop 15" : "+v"(p0), "+v"(p1));
}
__device__ __forceinline__ void pv8(f32x16* o, const char* Vb, const v8i& pa, int r32, int hi, int sc1) {
  asm volatile("s_nop 4" ::: "memory");
#pragma unroll
  for (int eb = 0; eb < 5; ++eb) { const int e = 32 * eb + r32; const int sw = (e >> 2) & 3; const char* rp = Vb + e * 64;
    const v8i vf = ldsrd32(rp + (((2 * hi) ^ sw) << 4), rp + (((2 * hi + 1) ^ sw) << 4));
    MFMA8_ACC(o[eb], pa, vf, sc1); }
}
__device__ __forceinline__ void attn_unit8(const unsigned char* __restrict__ QK8, const unsigned char* __restrict__ VT8, int qrow0, int krow0, int seq, int bh, int h, float lam, const float* __restrict__ nw, float oscale, bf16_t* __restrict__ MIX, char* lds, const int wave0) {
  const int tid = opaque_tid(wave0), wid = tid >> 6, lane = tid & 63, r32 = lane & 31, hi = lane >> 5;
  const int map = wid >> 2, wq = wid & 3;
  char* V_lds = lds; char* K_lds = lds + NB8 * V8B;
  float* ws = (float*)(lds + NB8 * V8B + NB8 * K8B) + wid * 64; float* al_l = ws + 32;
  int sc1 = 0x7F7F7F7F; asm volatile("" : "+v"(sc1));
  int sc8 = 0x72727272; asm volatile("" : "+v"(sc8));
  float m_reg = 0.f; f32x16 o[5] = {}; f32x16 negm;
#pragma unroll
  for (int r = 0; r < 16; ++r) negm[r] = P8_ONE;
  v8i q8;
  { const unsigned char* qp = QK8 + (size_t)(qrow0 + wq * QBLK + r32) * 1024 + h * 128 + map * 64 + hi * 32;
    const v4i a = *(const v4i*)qp, b = *(const v4i*)(qp + 16); q8 = __builtin_shufflevector(a, b, 0, 1, 2, 3, 4, 5, 6, 7); }
  const unsigned char* Kg = QK8 + K8T_OFF + (size_t)bh * (LT / 64) * 8192;
  const unsigned char* Vg = VT8 + (size_t)bh * (LT / 64) * 8192;
  const unsigned kgo = (unsigned)((tid >> 3) * 128 + (((tid & 7) ^ ((tid >> 4) & 7)) << 4)), vgo = (unsigned)((tid >> 2) * 64 + (((tid & 3) ^ ((tid >> 4) & 3)) << 4));
  const int wdst = __builtin_amdgcn_readfirstlane(wid) * 1024;
#define SDMA8(t, bb) do { const int b_ = (bb); \
    const unsigned char* kt_ = Kg + (size_t)(unsigned)(t) * 8192; const unsigned char* vt_ = Vg + (size_t)(unsigned)(t) * 8192; asm volatile("" : "+s"(kt_), "+s"(vt_));     \
    __builtin_amdgcn_global_load_lds((const unsigned*)(kt_ + kgo), (LAS unsigned*)(LAS char*)(K_lds + b_ * K8B + wdst), 16, 0, 0); \
    __builtin_amdgcn_global_load_lds((const unsigned*)(vt_ + vgo), (LAS unsigned*)(LAS char*)(V_lds + b_ * V8B + wdst), 16, 0, 0); } while (0)
#define TBAR8(n) do { asm volatile("s_waitcnt vmcnt(%0)\n\ts_waitcnt lgkmcnt(0)" :: "n"(n) : "memory"); __builtin_amdgcn_s_barrier(); asm volatile("" ::: "memory"); } while (0)
#define RESC8(a) do { if (__any((a) < 1.f)) { if (hi == 0) al_l[r32] = (a); asm volatile("s_nop 15\n\ts_nop 15\n\ts_waitcnt lgkmcnt(0)" ::: "memory"); \
    _Pragma("unroll") for (int d = 0; d < 5; ++d) _Pragma("unroll") for (int r = 0; r < 16; ++r) o[d][r] *= al_l[crow(r, hi)]; } } while (0)
  f32x16 pA0, pA1, pB0, pB1; float alA, alB; v8i pa; const int NT = seq / KVBLK;
#define KBUF8(b) (K_lds + (b) * K8B)
#define VBUF8(b) (V_lds + (b) * V8B)
  const int o8_ = opaque_int(0x38383838);
  for (int i = tid; i < NB8 * 128; i += 512) *(v4i*)(V_lds + (i >> 7) * V8B + 8192 + (i & 127) * 16) = (v4i){o8_, o8_, o8_, o8_};
#pragma unroll
  for (int t = 0; t <= DIST8; ++t) SDMA8(t < NT ? t : NT - 1, t);
  TBAR8(2 * DIST8);
  qkt8(pA0, pA1, KBUF8(0), q8, r32, hi, map, negm, sc1, sc8); partialSM8(pA0, pA1, m_reg, negm, alA);
  TBAR8(2 * (DIST8 - 2));
  const int kof0 = r32 * 128 + (((4 * map + 2 * hi) ^ ((r32 >> 1) & 7)) << 4), kof1 = r32 * 128 + (((4 * map + 2 * hi + 1) ^ ((r32 >> 1) & 7)) << 4);
  const int vof0 = r32 * 64 + (((2 * hi) ^ ((r32 >> 2) & 3)) << 4), vof1 = r32 * 64 + (((2 * hi + 1) ^ ((r32 >> 2) & 3)) << 4);
#define VF8(Vb_, f_) ldsrd32((Vb_) + vof0 + (f_) * 2048, (Vb_) + vof1 + (f_) * 2048)
  unsigned kl0 = (unsigned)(uintptr_t)(LAS char*)K_lds + (unsigned)kof0, kl1 = (unsigned)(uintptr_t)(LAS char*)K_lds + (unsigned)kof1; asm volatile("" : "+v"(kl0), "+v"(kl1));
#define KF8I(b_, f_) __builtin_shufflevector(*(const LAS v4i*)(uintptr_t)(kl0 + (unsigned)((b_) * K8B + (f_) * 4096)), *(const LAS v4i*)(uintptr_t)(kl1 + (unsigned)((b_) * K8B + (f_) * 4096)), 0, 1, 2, 3, 4, 5, 6, 7)
  v8i kf0 = KF8I(1, 0), kf1 = KF8I(1, 1);
#define HSTEP8(jt, pX0, pX1, alX, pY0, pY1, B1_, BN_, B2_) do { \
    const char* Vb_ = VBUF8(B1_); float mx_; \
    SBAR(); \
    MFMA8_NEW(pX0, kf0, q8, negm, sc1, sc8); \
    SBAR(); \
    v8i va_ = VF8(Vb_, 0), vb_ = VF8(Vb_, 1); const v8i vc_ = VF8(Vb_, 2); \
    _Pragma("unroll") for (int g = 0; g < 4; ++g) pa[g] = (int)pk4_u8(pY0[4 * g], pY0[4 * g + 1], pY0[4 * g + 2], pY0[4 * g + 3]); \
    SBAR(); \
    MFMA8_NEW(pX1, kf1, q8, negm, sc1, sc8); \
    SBAR(); \
    _Pragma("unroll") for (int g = 0; g < 4; ++g) pa[4 + g] = (int)pk4_u8(pY1[4 * g], pY1[4 * g + 1], pY1[4 * g + 2], pY1[4 * g + 3]); \
    { const int tn_ = (jt) + DIST8 < NT ? (jt) + DIST8 : NT - 1; SDMA8(tn_, B2_); }     \
    SBAR(); \
    asm volatile("s_nop 4" ::: "memory"); \
    MFMA8_ACC(o[0], pa, va_, sc1); va_ = VF8(Vb_, 3); SBAR(); \
    MFMA8_ACC(o[1], pa, vb_, sc1); vb_ = VF8(Vb_, 4); kf0 = KF8I(BN_, 0); kf1 = KF8I(BN_, 1); mx_ = max16(pX0, pX0[0]); SBAR(); \
    MFMA8_ACC(o[2], pa, vc_, sc1); mx_ = max16(pX1, mx_); SBAR(); \
    MFMA8_ACC(o[3], pa, va_, sc1); \
    MFMA8_ACC(o[4], pa, vb_, sc1); \
    if (__builtin_expect(!__all(mx_ <= P8_ONE + THR8), 0)) { decideSM8(mx_, pX0, pX1, negm, alX); RESC8(alX); }     \
    TBAR8(2 * (DIST8 - 2)); } while (0)
  int j = 1;
  for (; j + 6 <= NT - 1; j += 6) {
    HSTEP8(j,     pB0, pB1, alB, pA0, pA1, 0, 2, 5);
    HSTEP8(j + 1, pA0, pA1, alA, pB0, pB1, 1, 3, 0);
    HSTEP8(j + 2, pB0, pB1, alB, pA0, pA1, 2, 4, 1);
    HSTEP8(j + 3, pA0, pA1, alA, pB0, pB1, 3, 5, 2);
    HSTEP8(j + 4, pB0, pB1, alB, pA0, pA1, 4, 0, 3);
    HSTEP8(j + 5, pA0, pA1, alA, pB0, pB1, 5, 1, 4);
  }
  static_assert(NB8 == 6, "the unrolled trip walks a ring of six");
  for (; j + 1 < NT; j += 2) {
    const int c1 = (j - 1) % NB8, c0 = j % NB8, cn = (j + 1) % NB8, cnn = (j + 2) % NB8, c2 = (j + NB8 - 2) % NB8;
    HSTEP8(j,     pB0, pB1, alB, pA0, pA1, c1, cn, c2);
    HSTEP8(j + 1, pA0, pA1, alA, pB0, pB1, c0, cnn, c1);
  }
  const int b1 = (NT - 2) % NB8, b0 = (NT - 1) % NB8;
  SBAR(); MFMA8_NEW(pB0, kf0, q8, negm, sc1, sc8); MFMA8_NEW(pB1, kf1, q8, negm, sc1, sc8); SBAR();
  finishSM8(pA0, pA1, pa); SBAR();
  pv8(o, VBUF8(b1), pa, r32, hi, sc1); partialSM8(pB0, pB1, m_reg, negm, alB);
  RESC8(alB);
  finishSM8(pB0, pB1, pa); SBAR();
  pv8(o, VBUF8(b0), pa, r32, hi, sc1);
  asm volatile("s_nop 15\n\ts_nop 15" : "+v"(o[0]), "+v"(o[1]), "+v"(o[2]), "+v"(o[3]), "+v"(o[4]));
#undef HSTEP8
#undef VF8
#undef KF8I
#undef KBUF8
#undef VBUF8
#undef SDMA8
#undef TBAR8
  { const int tid_e = opaque_tid(wave0), lane_e = tid_e & 63; const int lane = lane_e, r32 = lane_e & 31, hi = lane_e >> 5, wid = tid_e >> 6, map = wid >> 2, wq = wid & 3; (void)map; (void)wq;
  float rli[16];
#pragma unroll
  for (int r = 0; r < 16; ++r) rli[r] = __builtin_amdgcn_rcpf(o[4][r]);
  asm volatile("s_waitcnt vmcnt(0)" ::: "memory");
  __syncthreads();
  float* stash = (float*)lds + wq * 4096;
  if (map == 1) {
#pragma unroll
    for (int d0 = 0; d0 < 4; ++d0)
#pragma unroll
      for (int r = 0; r < 16; ++r) stash[(d0 * 16 + r) * 64 + lane] = lam * o[d0][r] * rli[r];
  }
  __syncthreads();
  if (map == 0) {
    float rs[16];
#pragma unroll
    for (int r = 0; r < 16; ++r) {
      float ss = 0.f;
#pragma unroll
      for (int d0 = 0; d0 < 4; ++d0) { const float a = o[d0][r] * rli[r] - stash[(d0 * 16 + r) * 64 + lane]; o[d0][r] = a; ss += a * a; }
      rs[r] = ss;
    }
#pragma unroll
    for (int st = 1; st < 32; st <<= 1)
#pragma unroll
      for (int r = 0; r < 16; ++r) rs[r] += shfl_xor_l(rs[r], lane, st);
#pragma unroll
    for (int r = 0; r < 16; ++r) rs[r] = oscale * __builtin_amdgcn_rsqf(rs[r] * (1.0f / 128.0f) + EPS);
    float nwv[4];
#pragma unroll
    for (int d0 = 0; d0 < 4; ++d0) nwv[d0] = nw[d0 * 32 + r32];
    bf16_t* Ow = MIX + (size_t)(qrow0 + wq * QBLK) * D + h * 128;
#pragma unroll
    for (int r = 0; r < 16; ++r) { const int orow = crow(r, hi);
#pragma unroll
      for (int d0 = 0; d0 < 4; ++d0) Ow[(size_t)orow * D + d0 * 32 + r32] = f2bf(o[d0][r] * rs[r] * nwv[d0]); }
  }
  }
  __syncthreads();
#undef RESC8
}
}

struct Params {
    const float *x, *c, *ctx, *c_ctx, *w_in, *w_out, *ada_w, *ada_b, *norm1_w, *norm2_w, *diff_lambda, *diff_norm_w, *pool_w, *pool_scale,
                *ret_a_f, *ret_a_b, *ret_norm_w, *router_w, *router_b, *moe_g, *moe_u, *moe_d, *final_norm_w;
    float* out; unsigned char* ws;
};

__device__ __forceinline__ int rowmap(int kind, int n) {
    if (kind == 0) {
        const bool rope = (n < 1024) || (n >= OFF_RQ && n < OFF_RV);
        if (rope) { const int d = n & 63; return (n & ~63) + ((d >> 5) << 5) + ((d & 15) << 1) + ((d >> 4) & 1); }
        return n;
    } else if (kind == 1) return n;
    else {
        const int a = n >> 2, j = n & 3, bj = a & 1, t = a >> 1, fq = t & 3, wc = (t >> 2) & 3, pn = t >> 4;
        return pn * 256 + bj * 128 + wc * 32 + 8 * fq + j + (kind == 3 ? 4 : 0);
    }
}
__device__ __forceinline__ void transpose_item(const float* W, int K, int N, bf16_t* WT, int kind, float* scr, int item, int lane) {
    const int nblk = N / 32, kb = item / nblk, nb = item % nblk, k0 = 64 * kb, n0 = 32 * nb;
    float tv[32];
#pragma unroll
    for (int i = 0; i < 32; ++i) tv[i] = W[(size_t)(k0 + 2 * i + (lane >> 5)) * N + n0 + (lane & 31)];
#pragma unroll
    for (int i = 0; i < 32; ++i) scr[(2 * i + (lane >> 5)) * 33 + (lane & 31)] = tv[i];
    asm volatile("s_waitcnt lgkmcnt(0)" ::: "memory");
    const int c = lane & 7;
#pragma unroll
    for (int j = 0; j < 4; ++j) { const int n = (lane >> 3) + 8 * j; const float* s = scr + (8 * c) * 33 + n;
        u32x4 o; o.x = cvt_pk_bf16(s[0 * 33], s[1 * 33]); o.y = cvt_pk_bf16(s[2 * 33], s[3 * 33]); o.z = cvt_pk_bf16(s[4 * 33], s[5 * 33]); o.w = cvt_pk_bf16(s[6 * 33], s[7 * 33]);
        *(u32x4*)(WT + (size_t)rowmap(kind, n0 + n) * K + k0 + 8 * c) = o; }
    asm volatile("s_waitcnt lgkmcnt(0)" ::: "memory");
}

__device__ __forceinline__ const void* ldp(volatile LAS unsigned* tab, int k) {
    const unsigned lo = tab[2 * k], hi = tab[2 * k + 1];
    const unsigned long long v = ((unsigned long long)(unsigned)__builtin_amdgcn_readfirstlane(hi) << 32) | (unsigned long long)(unsigned)__builtin_amdgcn_readfirstlane(lo);
    const GAS char* g = (const GAS char*)v;
    return (const void*)g;
}
enum { I_X = 0, I_C, I_CTX, I_CCTX, I_WIN, I_WOUT, I_ADAW, I_ADAB, I_N1W, I_N2W, I_DLAM, I_DNW, I_POOLW, I_POOLS, I_RAF, I_RAB, I_RNW, I_RW, I_RB, I_MG, I_MU, I_MD, I_FNW, I_OUT, I_WS };
__device__ __forceinline__ void transpose_item_fp8(const float* W, int K, int N, unsigned char* WT, int kind, float* scr, int item, int lane) {
    const int nblk = N / 32, kb = item / nblk, nb = item % nblk, k0 = 64 * kb, n0 = 32 * nb;
    float tv[32];
#pragma unroll
    for (int i = 0; i < 32; ++i) tv[i] = W[(size_t)(k0 + 2 * i + (lane >> 5)) * N + n0 + (lane & 31)];
#pragma unroll
    for (int i = 0; i < 32; ++i) scr[(2 * i + (lane >> 5)) * 33 + (lane & 31)] = tv[i];
    asm volatile("s_waitcnt lgkmcnt(0)" ::: "memory");
    const int c = lane & 7;
#pragma unroll
    for (int j = 0; j < 4; ++j) { const int n = (lane >> 3) + 8 * j; const float* sp = scr + (8 * c) * 33 + n;
        u32x2 o; o.x = pk4_fp8(sp[0 * 33] * pg8::WSCALE, sp[1 * 33] * pg8::WSCALE, sp[2 * 33] * pg8::WSCALE, sp[3 * 33] * pg8::WSCALE);
        o.y = pk4_fp8(sp[4 * 33] * pg8::WSCALE, sp[5 * 33] * pg8::WSCALE, sp[6 * 33] * pg8::WSCALE, sp[7 * 33] * pg8::WSCALE);
        *(u32x2*)(WT + (size_t)rowmap(kind, n0 + n) * K + k0 + 8 * c) = o; }
    asm volatile("s_waitcnt lgkmcnt(0)" ::: "memory");
}
#ifndef PHMASK
#define PHMASK 0xFFFF
#endif
#define PH(k) if (PHMASK & (1 << (k)))
#ifndef DUPMASK
#define DUPMASK 0
#endif
#define REP(k) for (int rep_ = 0, nrep_ = opaque_int(((DUPMASK >> (k)) & 1) + 1); rep_ < nrep_; ++rep_)
__global__ void __launch_bounds__(512, 2) fwd_kernel(Params p) {
    extern __shared__ __attribute__((aligned(16))) unsigned char lds_all[];
    const int tid = threadIdx.x;
    const int wave0 = __builtin_amdgcn_readfirstlane(tid >> 6);
    const int G0 = gridDim.x; const int bx0 = blockIdx.x;
    const int vcu0 = (G0 % 8 == 0) ? (bx0 % 8) * (G0 / 8) + bx0 / 8 : bx0;
    LAS unsigned char* ldsc = (LAS unsigned char*)lds_all;
    volatile LAS unsigned* LP = (volatile LAS unsigned*)(ldsc + LC_PTR);
#define INP(k) ((const float*)ldp(LP, (k)))
#define WSP() ((unsigned char*)ldp(LP, I_WS))
#define OUTP() ((float*)ldp(LP, I_OUT))
    for (int u = tid; u < LDSCTL_BYTES / 4; u += 512) ((LAS unsigned*)ldsc)[u] = 0u;
    __syncthreads();
    if (tid == 0) {
        volatile LAS unsigned long long* T = (volatile LAS unsigned long long*)(ldsc + LC_PTR);
        T[I_X] = (unsigned long long)p.x; T[I_C] = (unsigned long long)p.c; T[I_CTX] = (unsigned long long)p.ctx; T[I_CCTX] = (unsigned long long)p.c_ctx;
        T[I_WIN] = (unsigned long long)p.w_in; T[I_WOUT] = (unsigned long long)p.w_out; T[I_ADAW] = (unsigned long long)p.ada_w; T[I_ADAB] = (unsigned long long)p.ada_b;
        T[I_N1W] = (unsigned long long)p.norm1_w; T[I_N2W] = (unsigned long long)p.norm2_w; T[I_DLAM] = (unsigned long long)p.diff_lambda; T[I_DNW] = (unsigned long long)p.diff_norm_w;
        T[I_POOLW] = (unsigned long long)p.pool_w; T[I_POOLS] = (unsigned long long)p.pool_scale; T[I_RAF] = (unsigned long long)p.ret_a_f; T[I_RAB] = (unsigned long long)p.ret_a_b;
        T[I_RNW] = (unsigned long long)p.ret_norm_w; T[I_RW] = (unsigned long long)p.router_w; T[I_RB] = (unsigned long long)p.router_b; T[I_MG] = (unsigned long long)p.moe_g;
        T[I_MU] = (unsigned long long)p.moe_u; T[I_MD] = (unsigned long long)p.moe_d; T[I_FNW] = (unsigned long long)p.final_norm_w; T[I_OUT] = (unsigned long long)p.out; T[I_WS] = (unsigned long long)p.ws;
    }
    __syncthreads();
    XcdBarrier bar = xcd_barrier_post((unsigned*)(WSP() + WS_CTL) + CW_BAR, (volatile LAS unsigned*)(ldsc + LC_BARW));
#define GRID_BAR() xcd_barrier(bar)
#define WSPTRS() const int tid = opaque_tid(wave0), lane = tid & 63, wave = __builtin_amdgcn_readfirstlane(tid >> 6); const int G = opaque_int(G0), bx = opaque_int(bx0), vcu = opaque_int(vcu0), NGW = G * 8; const int gw = vcu * 8 + wave; \
    unsigned char* const lds = lds_all + opaque_int(RING_OFF); LAS unsigned char* ldsl = (LAS unsigned char*)lds; (void)lane; (void)gw; (void)bx; (void)NGW; (void)ldsl; unsigned char* ws = WSP(); unsigned* ctl = (unsigned*)(ws + WS_CTL); float* MODV = (float*)(ws + WS_MOD); float* ROPEC = (float*)(ws + WS_ROPE); float* ROPES = ROPEC + 1024; \
    bf16_t* POOLWT = (bf16_t*)(ws + WS_POOLW); float* GATE = (float*)(ws + WS_GATE); int* TOK = (int*)(ws + WS_TOK); float* XC = (float*)(ws + WS_XC); float* KV = (float*)(ws + WS_KV); \
    bf16_t* ST = (bf16_t*)(ws + WS_ST); bf16_t* WIN = (bf16_t*)(ws + WS_WIN); bf16_t* WOUT = (bf16_t*)(ws + WS_WOUT); unsigned char* WGU = ws + WS_WGU; unsigned char* WDN = ws + WS_WDN; unsigned char* H8 = ws + WS_H8; unsigned char* QK8 = ws + WS_QK8; unsigned char* VT8 = ws + WS_VT8; (void)QK8; (void)VT8; \
    bf16_t* H = (bf16_t*)(ws + WS_H); bf16_t* XB = (bf16_t*)(ws + WS_XB); (void)XB; bf16_t* P = (bf16_t*)(ws + WS_P); bf16_t* MIX = (bf16_t*)(ws + WS_MIX); unsigned char* ACT = ws + WS_ACT; unsigned char* Y2 = ws + WS_Y2; float* OUT = OUTP(); \
    (void)ctl; (void)MODV; (void)ROPEC; (void)ROPES; (void)POOLWT; (void)GATE; (void)TOK; (void)XC; (void)KV; (void)ST; (void)WIN; (void)WOUT; (void)WGU; (void)WDN; (void)H8; (void)H; (void)P; (void)MIX; (void)ACT; (void)Y2; (void)OUT

    PH(0) REP(0) { WSPTRS();
        float* scr = (float*)(lds + wave * 8448);
        for (int mb = vcu; mb < 192 + 17; mb += G) {
        if (mb < 192) {
            float* sil = (float*)(lds + 72 * 1024);
            float* part = (float*)(lds + 108 * 1024);
            for (int i = tid; i < 9 * 1024; i += 512) { const int r = i >> 10, k = i & 1023; const float cv = (r < 8) ? INP(I_C)[r * 1024 + k] : INP(I_CCTX)[k]; sil[i] = cv / (1.0f + expf(-cv)); }
            __syncthreads();
            const int l = mb / 48, n0 = (mb - l * 48) * 128, cl = (wave & 1) * 64 + lane, kq = wave >> 1;
            const float* wp = INP(I_ADAW) + (size_t)l * 1024 * 6144 + (size_t)(kq * 256) * 6144 + n0 + cl;
            float a[9];
#pragma unroll
            for (int r = 0; r < 9; ++r) a[r] = 0.f;
            for (int k = 0; k < 256; k += 16) {
                float wv[16];
#pragma unroll
                for (int q = 0; q < 16; ++q) wv[q] = wp[(size_t)(k + q) * 6144];
#pragma unroll
                for (int q4 = 0; q4 < 4; ++q4)
#pragma unroll
                    for (int r = 0; r < 9; ++r) { const f32x4 s4 = *(const f32x4*)(sil + r * 1024 + kq * 256 + k + 4 * q4);
                        a[r] += (s4[0] * wv[4 * q4] + s4[1] * wv[4 * q4 + 1]) + (s4[2] * wv[4 * q4 + 2] + s4[3] * wv[4 * q4 + 3]); }
            }
#pragma unroll
            for (int r = 0; r < 9; ++r) part[(kq * 9 + r) * 128 + cl] = a[r];
            __syncthreads();
            for (int i = tid; i < 9 * 128; i += 512) { const int r = i >> 7, c = i & 127;
                MODV[((size_t)l * 9 + r) * 6144 + n0 + c] = INP(I_ADAB)[l * 6144 + n0 + c] + ((part[(0 * 9 + r) * 128 + c] + part[(1 * 9 + r) * 128 + c]) + (part[(2 * 9 + r) * 128 + c] + part[(3 * 9 + r) * 128 + c])); }
            __syncthreads();
        }
        if (mb == 192) {
            for (int i = tid; i < 1024; i += 512) { const int pos = i >> 4, f = i & 15; const double inv = pow(10000.0, -(double)f / 16.0); const double ang = (double)pos * inv; ROPEC[i] = (float)cos(ang); ROPES[i] = (float)sin(ang); }
        }
        if (mb >= 193) {
            const int lg = mb - 193;
            for (int i = tid; i < 4096; i += 512) { const int j = i >> 6, c = i & 63; POOLWT[(size_t)lg * 4096 + i] = f2bf(INP(I_POOLW)[(size_t)lg * 4096 + c * 64 + j]); }
        }
        }
        constexpr int I_IN = 16 * 44, I_OUT = 16 * 16, I_L = I_IN + I_OUT, I_E = 192, I_DENSE = 4 * I_L, NITEMS = I_DENSE + 64 * 3 * I_E;
        for (int it = gw; it < NITEMS; it += NGW) {
            const float* W_; unsigned char* dst_; int N_, K_, kind_, fp8_, item_;
            if (it < I_DENSE) { const int l_ = it / I_L, r_ = it - l_ * I_L;
                if (r_ < I_IN) { W_ = INP(I_WIN) + (size_t)l_ * 1024 * INW; K_ = 1024; N_ = INW; dst_ = (unsigned char*)WIN + (size_t)l_ * INW * 1024; kind_ = 0; fp8_ = 1; item_ = r_; }
                else { W_ = INP(I_WOUT) + (size_t)l_ * 1024 * 1024; K_ = 1024; N_ = 1024; dst_ = (unsigned char*)(WOUT + (size_t)l_ * 1024 * 1024); kind_ = 1; fp8_ = 0; item_ = r_ - I_IN; }
            } else { const int j_ = it - I_DENSE, le_ = j_ / (3 * I_E), r_ = j_ - le_ * 3 * I_E, which_ = r_ / I_E; item_ = r_ - which_ * I_E; fp8_ = 1;
                if (which_ == 0) { W_ = INP(I_MG) + (size_t)le_ * 1024 * DE; K_ = 1024; N_ = DE; dst_ = WGU + (size_t)le_ * NGU * 1024; kind_ = 2; }
                else if (which_ == 1) { W_ = INP(I_MU) + (size_t)le_ * 1024 * DE; K_ = 1024; N_ = DE; dst_ = WGU + (size_t)le_ * NGU * 1024; kind_ = 3; }
                else { W_ = INP(I_MD) + (size_t)le_ * DE * 1024; K_ = DE; N_ = 1024; dst_ = WDN + (size_t)le_ * 1024 * DE; kind_ = 1; } }
            const int nblk_ = N_ / 64, kb_ = item_ / nblk_, nb_ = item_ - kb_ * nblk_, k0_ = 64 * kb_, n_ = 64 * nb_ + lane;
            float tv[64];
            { const float* p_ = W_ + (size_t)k0_ * N_ + n_; const size_t st_ = (size_t)N_;
#pragma unroll
              for (int i = 0; i < 64; ++i) { tv[i] = *p_; p_ += st_; asm volatile("" : "+v"(p_)); } }
            const size_t drow = (size_t)rowmap(kind_, n_) * K_ + k0_;
            if (fp8_) {
#pragma unroll
                for (int j = 0; j < 4; ++j) { u32x4 o;
#pragma unroll
                    for (int q = 0; q < 4; ++q) o[q] = pk4_fp8(tv[16 * j + 4 * q] * pg8::WSCALE, tv[16 * j + 4 * q + 1] * pg8::WSCALE, tv[16 * j + 4 * q + 2] * pg8::WSCALE, tv[16 * j + 4 * q + 3] * pg8::WSCALE);
                    *(u32x4*)(dst_ + drow + 16 * j) = o; }
            } else {
#pragma unroll
                for (int j = 0; j < 8; ++j) { u32x4 o;
#pragma unroll
                    for (int q = 0; q < 4; ++q) o[q] = cvt_pk_bf16(tv[8 * j + 2 * q], tv[8 * j + 2 * q + 1]);
                    *(u32x4*)((bf16_t*)dst_ + drow + 8 * j) = o; }
            }
        }
    }
    GRID_BAR();

    for (int l = 0; l < DEPTH; ++l) {
        const bool last = (l == DEPTH - 1);
        const float lam_init = 0.8f - 0.6f * expf(-0.3f * (float)l);
        PH(1) REP(1) { WSPTRS(); const float* modl = MODV + (size_t)l * 9 * 6144;
            const float* nw = INP(I_N1W) + l * D;
            const float* xin = INP(I_X); const float* cin = INP(I_CTX);
            const int CH = (M + NGW - 1) / NGW;
            const int r0 = gw * CH, r1 = (r0 + CH < M) ? r0 + CH : M;
            int curvar = -1;
            f32x4 wsc[4] = {}, shv[4] = {}, g2v[4] = {};
            f32x4 xv[4] = {}; unsigned ya[4] = {}, yb[4] = {};
#define N1_SRC(row_, ptr_) do { const int b_ = (row_) / LT, j_ = (row_) - b_ * LT; const bool c_ = j_ < LC; const size_t xo_ = c_ ? ((size_t)(b_ * LC + j_)) * D : ((size_t)(b_ * L + j_ - LC)) * D; \
        ptr_ = (c_ ? cin : xin) + xo_; } while (0)
#define N1_LOAD(row_, X_, A_, B_) do { if (l == 0) { const float* sp_; N1_SRC(row_, sp_); _Pragma("unroll") for (int jj = 0; jj < 4; ++jj) X_[jj] = *(const f32x4*)(sp_ + 4 * lane + 256 * jj); } \
        else { _Pragma("unroll") for (int jj = 0; jj < 4; ++jj) X_[jj] = bf4_to_f4(*(const u32x2*)(XB + (size_t)(row_) * D + 4 * lane + 256 * jj)); } \
        if (l > 0) { const unsigned char* y0_ = Y2 + (size_t)(2 * (row_)) * D; _Pragma("unroll") for (int jj = 0; jj < 4; ++jj) { A_[jj] = *(const unsigned*)(y0_ + 4 * lane + 256 * jj); B_[jj] = *(const unsigned*)(y0_ + D + 4 * lane + 256 * jj); } } } while (0)
            if (r0 < r1) N1_LOAD(r0, xv, ya, yb);
            for (int row = r0; row < r1; ++row) {
                f32x4 xn[4] = {}; unsigned yan[4] = {}, ybn[4] = {};
                if (row + 1 < r1) N1_LOAD(row + 1, xn, yan, ybn);
                const int b = row / LT, j = row - b * LT; const bool isctx = j < LC; const int var = isctx ? 8 : b;
                if (var != curvar) {
                    curvar = var;
                    const float* mod = modl + (size_t)var * 6144;
                    const float* g2 = MODV + ((size_t)(l > 0 ? l - 1 : 0) * 9 + var) * 6144 + 5 * 1024;
#pragma unroll
                    for (int jj = 0; jj < 4; ++jj) { const int cc = 4 * lane + 256 * jj; wsc[jj] = *(const f32x4*)(nw + cc) * (*(const f32x4*)(mod + 1024 + cc) + 1.0f); shv[jj] = *(const f32x4*)(mod + cc); g2v[jj] = *(const f32x4*)(g2 + cc) * pg8::YINV; }
                }
                if (l > 0) {
#pragma unroll
                    for (int jj = 0; jj < 4; ++jj) { xv[jj] = xv[jj] + g2v[jj] * (fp8x4_to_f4(ya[jj]) + fp8x4_to_f4(yb[jj]));
                        u32x2 w; w.x = cvt_pk_bf16(xv[jj][0], xv[jj][1]); w.y = cvt_pk_bf16(xv[jj][2], xv[jj][3]); *(u32x2*)(XB + (size_t)row * D + 4 * lane + 256 * jj) = w; xv[jj] = bf4_to_f4(w); }
                }
                float ss = 0.f;
#pragma unroll
                for (int jj = 0; jj < 4; ++jj) ss += (xv[jj][0] * xv[jj][0] + xv[jj][1] * xv[jj][1]) + (xv[jj][2] * xv[jj][2] + xv[jj][3] * xv[jj][3]);
                ss = wave_sum(ss, lane);
                const float rstd = __builtin_amdgcn_rsqf(ss * (1.0f / D) + EPS);
#pragma unroll
                for (int jj = 0; jj < 4; ++jj) {
                    const f32x4 hv = xv[jj] * rstd * wsc[jj] + shv[jj];
                    *(unsigned*)((unsigned char*)H + (size_t)row * D + 4 * lane + 256 * jj) = pk4_fp8(hv[0], hv[1], hv[2], hv[3]);
                }
#pragma unroll
                for (int jj = 0; jj < 4; ++jj) { xv[jj] = xn[jj]; ya[jj] = yan[jj]; yb[jj] = ybn[jj]; }
            }
#undef N1_SRC
#undef N1_LOAD
        }
        GRID_BAR();
        PH(2) REP(2) { WSPTRS();
            pg8::DenseSched S; S.init(M, INW, D, G, bx, (unsigned char*)WIN + (size_t)l * INW * 1024, false, 1);
            pg8::EpiG1 E{P, ROPEC, ROPES, QK8};
            pg8::gemm_phase<pg8::EpiG1, pg8::DenseSched, true>(ldsl, (const char*)H, D, S, E, wave0);
        }
        GRID_BAR();
        PH(3) REP(3) { WSPTRS();
            {
                using namespace att;
                char* Vi = (char*)lds; char* Kf = (char*)lds + 16384; char* Kb = (char*)lds + 32768;
                const int dir = wave >> 2, eb = (wave >> 1) & 1, db = wave & 1, r32 = lane & 31, hi = lane >> 5;
                for (int it = vcu; it < NB * NCH * 4; it += G) {
                    const int h = it & 3, bc = it >> 2, b = bc / NCH, ch = bc - b * NCH;
                    const int rowbase = b * LT + ch * 128;
                    const float lgf2 = -expf(INP(I_RAF)[l * 4 + h]) * LOG2E, lgb2 = -expf(INP(I_RAB)[l * 4 + h]) * LOG2E;
#pragma unroll
                    for (int i = 0; i < 2; ++i) { const int chunk = tid + 512 * i, c = chunk >> 3, c8 = (chunk & 7) * 8;
                        const int off = (c >> 6) * 8192 + v_st<2>(c & 63, c8);
                        *(bf16x8*)(Vi + off) = *(const bf16x8*)(P + (size_t)(rowbase + c) * INW + OFF_RV + h * 64 + c8);
                        const bf16x8 kk = *(const bf16x8*)(P + (size_t)(rowbase + c) * INW + OFF_RK + h * 64 + c8);
                        const float zf = __builtin_amdgcn_exp2f(lgf2 * (float)(127 - c)), zb = __builtin_amdgcn_exp2f(lgb2 * (float)c);
                        u32x4 wf, wb;
#pragma unroll
                        for (int z = 0; z < 4; ++z) { const float a0 = bf2f((bf16_t)kk[2 * z]), a1 = bf2f((bf16_t)kk[2 * z + 1]); wf[z] = cvt_pk_bf16(a0 * zf, a1 * zf); wb[z] = cvt_pk_bf16(a0 * zb, a1 * zb); }
                        *(u32x4*)(Kf + off) = wf; *(u32x4*)(Kb + off) = wb; }
                    __syncthreads();
                    f32x16 acc = {};
                    const int vbase = (int)(uintptr_t)Vi + v_rd_base(lane) + eb * 512;
                    const int kbase = (int)(uintptr_t)(dir ? Kb : Kf) + v_rd_base(lane) + db * 512;
#pragma unroll
                    for (int tt = 0; tt < 2; ++tt)
#pragma unroll
                        for (int ks = 0; ks < 4; ++ks) {
                            s16x4 al, ah, bl, bh;
                            asm volatile("ds_read_b64_tr_b16 %0, %1 offset:%2" : "=&v"(al) : "v"(vbase), "i"(tt * 8192 + ks * 2048) : "memory");
                            asm volatile("ds_read_b64_tr_b16 %0, %1 offset:%2" : "=&v"(ah) : "v"(vbase), "i"(tt * 8192 + ks * 2048 + 1024) : "memory");
                            asm volatile("ds_read_b64_tr_b16 %0, %1 offset:%2" : "=&v"(bl) : "v"(kbase), "i"(tt * 8192 + ks * 2048) : "memory");
                            asm volatile("ds_read_b64_tr_b16 %0, %1 offset:%2" : "=&v"(bh) : "v"(kbase), "i"(tt * 8192 + ks * 2048 + 1024) : "memory");
                            asm volatile("s_waitcnt lgkmcnt(0)" ::: "memory"); SBAR();
                            const bf16x8 av = (bf16x8){al[0], al[1], al[2], al[3], ah[0], ah[1], ah[2], ah[3]}, bv = (bf16x8){bl[0], bl[1], bl[2], bl[3], bh[0], bh[1], bh[2], bh[3]};
                            acc = __builtin_amdgcn_mfma_f32_32x32x16_bf16(av, bv, acc, 0, 0, 0);
                        }
                    float* op = KV + ((size_t)(((b * 4 + h) * 2 + dir) * NCH + ch)) * 4096 + (size_t)(eb * 32) * 64 + db * 32 + r32;
#pragma unroll
                    for (int r = 0; r < 16; ++r) op[crow(r, hi) * 64] = acc[r];
                    __syncthreads();
                }
            }
            {
                bf16_t* Vt = (bf16_t*)lds;
                for (int it = vcu; it < NB * 4 * (LT / 64); it += G) {
                    const int t = it % (LT / 64), bh = it / (LT / 64), b = bh >> 2, h = bh & 3;
                    const size_t row0 = (size_t)b * LT + (size_t)t * 64;
#pragma unroll
                    for (int i = 0; i < 2; ++i) { const int chunk = tid + 512 * i, key = chunk >> 4, c8 = (chunk & 15) * 8;
                        *(bf16x8*)(Vt + key * 136 + c8) = *(const bf16x8*)(P + (row0 + key) * INW + OFF_DV + h * 128 + c8); }
                    __syncthreads();
                    { const int e = tid >> 2, q = tid & 3, hi2 = q >> 1, sb = 16 * (q & 1);
                      float v[16];
#pragma unroll
                      for (int jx = 0; jx < 16; ++jx) { const int sx = sb + jx; const int key = (sx < 16) ? ((sx & 3) + 8 * (sx >> 2) + 4 * hi2) : (32 + ((sx - 16) & 3) + 8 * ((sx - 16) >> 2) + 4 * hi2); v[jx] = bf2f(Vt[key * 136 + e]); }
                      u32x4 w; w.x = pk4_fp8(v[0], v[1], v[2], v[3]); w.y = pk4_fp8(v[4], v[5], v[6], v[7]); w.z = pk4_fp8(v[8], v[9], v[10], v[11]); w.w = pk4_fp8(v[12], v[13], v[14], v[15]);
                      *(u32x4*)(VT8 + (size_t)it * 8192 + e * 64 + q * 16) = w; }
                    __syncthreads();
                }
            }
        }
        GRID_BAR();
        PH(4) REP(4) { WSPTRS();
            const int nskip = (!last && G > 128) ? 64 : 0;
            if (vcu >= nskip) for (int idx = (vcu - nskip) * 512 + tid; idx < 64 * 4096; idx += (G - nskip) * 512) {
                const int scan = idx >> 12, el = idx & 4095, dir = scan & 1, h = (scan >> 1) & 3;
                const float lg2 = -expf(dir ? INP(I_RAB)[l * 4 + h] : INP(I_RAF)[l * 4 + h]) * LOG2E;
                const float g = __builtin_amdgcn_exp2f(lg2 * 128.0f);
                const float* base = KV + (size_t)scan * NCH * 4096 + el;
                bf16_t* sb = ST + (size_t)scan * NCH * 4096 + el;
                float v[NCH];
#pragma unroll
                for (int ch = 0; ch < NCH; ++ch) v[ch] = base[(size_t)ch * 4096];
                float st = 0.f;
                if (dir == 0) {
#pragma unroll
                    for (int ch = 0; ch < NCH; ++ch) { sb[(size_t)ch * 4096] = f2bf(st); st = g * st + v[ch]; }
                } else {
                    sb[(size_t)1 * 4096] = f2bf(st); st = g * st + v[1];
                    sb[(size_t)0 * 4096] = f2bf(st); st = g * st + v[0];
#pragma unroll
                    for (int ch = NCH - 1; ch >= 2; --ch) { sb[(size_t)ch * 4096] = f2bf(st); st = g * st + v[ch]; }
                }
            }
            const float* dl = INP(I_DLAM) + l * 256;
            const float s1 = wave_sum(dl[lane] * dl[64 + lane], lane), s2 = wave_sum(dl[128 + lane] * dl[192 + lane], lane);
            const float lam = expf(s1) - expf(s2) + lam_init;
            const float* nw = INP(I_DNW) + l * 128;
            const float oscale = 1.0f - lam_init;
            const int nlat = NB * 4 * 32, nunits = nlat + (last ? 0 : 64);
            for (int Lx = vcu; Lx < nunits; Lx += G) {
                int qrow0, krow0, seq, h, bh;
                if (Lx < nlat) { bh = Lx >> 5; const int qb = Lx & 31, b = bh >> 2; h = bh & 3; qrow0 = b * LT + LC + qb * 128; krow0 = b * LT; seq = LT; }
                else { const int c_ = Lx - nlat; bh = c_ >> 1; const int qb = c_ & 1, b = bh >> 2; h = bh & 3; qrow0 = b * LT + qb * 128; krow0 = b * LT; seq = LC; }
                att::attn_unit8(QK8, VT8, qrow0, krow0, seq, bh, h, lam, nw, oscale, MIX, (char*)lds, wave0);
            }
        }
        GRID_BAR();
        PH(5) REP(5) { WSPTRS();
            using namespace att;
            const bool g2c = !last && G == 256;
            const int GW = g2c ? G - 32 : G, nctx = last ? 0 : 32;
            unsigned* ctxcnt = ctl + CW_CTX + 64 * l;
            if (g2c && vcu >= GW) {
                if (rep_ == 0) {
                if (tid == 0) { unsigned sp_ = 0; while (xb_ld(ctxcnt) < 64u) { __builtin_amdgcn_s_sleep(2); if (++sp_ > (1u << 22)) break; }
                    __builtin_amdgcn_fence(__ATOMIC_ACQUIRE, "agent"); asm volatile("s_waitcnt vmcnt(0)" ::: "memory"); }
                __syncthreads();
                const int k = vcu - GW; const float* modl = MODV + (size_t)l * 9 * 6144;
                pg8::OneSched S{(k >> 2) * 17, k & 3, (const char*)(WOUT + (size_t)l * 1024 * 1024), 2 * D};
                pg8::EpiG2 E{INP(I_X), INP(I_CTX), XB, modl, l == 0};
                pg8::gemm_phase<pg8::EpiG2, pg8::OneSched>(ldsl, (const char*)MIX, D, S, E, wave0);
                }
            } else
            for (int pass = (nctx ? 0 : 1); pass < 2; ++pass) {
            const int nret = pass == 0 ? nctx : 512;
            for (int p = pass == 0 ? vcu : (vcu + GW - 64) % GW; p < nret; p += GW) {
                int b, ch, hp;
                if (pass == 0) { b = p >> 2; ch = (p >> 1) & 1; hp = p & 1; } else { b = p >> 6; ch = 2 + ((p >> 1) & 31); hp = p & 1; }
                const int wq = wave & 3, hh = wave >> 2, h = hp * 2 + hh, r32 = lane & 31, hi = lane >> 5;
                const int rowbase = b * LT + ch * 128;
                const float lgf2 = -expf(INP(I_RAF)[l * 4 + h]) * LOG2E, lgb2 = -expf(INP(I_RAB)[l * 4 + h]) * LOG2E;
                char* Hl = (char*)lds + hh * 49152; char* Vl = Hl; char* Kl = Hl + 16384; char* Fl = Hl + 32768; char* Bl = Hl + 40960;
                {
                    const int t4 = tid & 255;
                    const bf16_t* Ft = ST + ((size_t)(((b * 4 + h) * 2 + 0) * NCH + ch)) * 4096;
                    const bf16_t* Bt = ST + ((size_t)(((b * 4 + h) * 2 + 1) * NCH + ch)) * 4096;
                    bf16x8 lv[4], lk[4], lf[2], lb[2];
#pragma unroll
                    for (int i = 0; i < 4; ++i) { const int chunk = t4 + 256 * i, k = chunk >> 3, c8 = (chunk & 7) * 8;
                        lv[i] = *(const bf16x8*)(P + (size_t)(rowbase + k) * INW + OFF_RV + h * 64 + c8);
                        lk[i] = *(const bf16x8*)(P + (size_t)(rowbase + k) * INW + OFF_RK + h * 64 + c8); }
#pragma unroll
                    for (int i = 0; i < 2; ++i) { const int chunk = t4 + 256 * i; lf[i] = *(const bf16x8*)(Ft + chunk * 8); lb[i] = *(const bf16x8*)(Bt + chunk * 8); }
#pragma unroll
                    for (int i = 0; i < 4; ++i) { const int chunk = t4 + 256 * i, k = chunk >> 3, c = chunk & 7;
                        *(bf16x8*)(Vl + (k >> 6) * 8192 + v_st<2>(k & 63, c * 8)) = lv[i];
                        *(bf16x8*)(Kl + k * 128 + ((c ^ (k & 7)) << 4)) = lk[i]; }
#pragma unroll
                    for (int i = 0; i < 2; ++i) { const int chunk = t4 + 256 * i, e = chunk >> 3, c = chunk & 7;
                        *(bf16x8*)(Fl + e * 128 + ((c ^ (e & 7)) << 4)) = lf[i]; *(bf16x8*)(Bl + e * 128 + ((c ^ (e & 7)) << 4)) = lb[i]; }
                }
                const int cq = wq * 32 + r32;
                bf16x8 qr[4];
                const bf16_t* Qw = P + (size_t)(rowbase + cq) * INW + OFF_RQ + h * 64 + hi * 8;
#pragma unroll
                for (int d0 = 0; d0 < 4; ++d0) qr[d0] = ld8(Qw + d0 * 16);
                __syncthreads();
                f32x16 o[2] = {};
                const int vb = (int)(uintptr_t)Vl + v_rd_base(lane);
#pragma unroll 1
                for (int tt = 0; tt < 2; ++tt) {
                    f32x16 p0 = {}, p1 = {};
                    const char* Ka = Kl + (tt * 64 + r32) * 128; const char* Kb2 = Ka + 32 * 128;
#pragma unroll
                    for (int d0 = 0; d0 < 4; ++d0) {
                        const int c = ((2 * d0 + hi) ^ (r32 & 7)) << 4;
                        const bf16x8 k0 = *(const bf16x8*)(Ka + c), k1 = *(const bf16x8*)(Kb2 + c);
                        p0 = __builtin_amdgcn_mfma_f32_32x32x16_bf16(k0, qr[d0], p0, 0, 0, 0);
                        p1 = __builtin_amdgcn_mfma_f32_32x32x16_bf16(k1, qr[d0], p1, 0, 0, 0);
                    }
#pragma unroll
                    for (int r = 0; r < 16; ++r) {
                        const int s0 = tt * 64 + crow(r, hi);
                        const int d0_ = cq - s0, d1_ = cq - (s0 + 32);
                        const float w0 = d0_ >= 0 ? __builtin_amdgcn_exp2f(lgf2 * (float)d0_) : __builtin_amdgcn_exp2f(lgb2 * (float)(-d0_));
                        const float w1 = d1_ >= 0 ? __builtin_amdgcn_exp2f(lgf2 * (float)d1_) : __builtin_amdgcn_exp2f(lgb2 * (float)(-d1_));
                        p0[r] *= w0; p1[r] *= w1;
                    }
                    bf16x8 pa0, pa1, pa2, pa3;
                    PK4(p0, 0, pa0); PK4(p0, 8, pa1); PK4(p1, 0, pa2); PK4(p1, 8, pa3);
                    pv2(o, vb + tt * 8192, pa0, pa1, pa2, pa3);
                }
                {
                    const float xf = __builtin_amdgcn_exp2f(lgf2 * (float)(cq + 1)), xb = __builtin_amdgcn_exp2f(lgb2 * (float)(128 - cq));
#pragma unroll
                    for (int d0 = 0; d0 < 4; ++d0) {
                        u32x4 qf, qb;
#pragma unroll
                        for (int z = 0; z < 4; ++z) { const float a0 = bf2f((bf16_t)qr[d0][2 * z]), a1 = bf2f((bf16_t)qr[d0][2 * z + 1]); qf[z] = cvtpk(a0 * xf, a1 * xf); qb[z] = cvtpk(a0 * xb, a1 * xb); }
                        const bf16x8 qfv = *reinterpret_cast<bf16x8*>(&qf), qbv = *reinterpret_cast<bf16x8*>(&qb);
#pragma unroll
                        for (int eb = 0; eb < 2; ++eb) {
                            const int e = eb * 32 + r32; const int c = ((2 * d0 + hi) ^ (e & 7)) << 4;
                            const bf16x8 f0 = *(const bf16x8*)(Fl + e * 128 + c), b0 = *(const bf16x8*)(Bl + e * 128 + c);
                            o[eb] = __builtin_amdgcn_mfma_f32_32x32x16_bf16(qfv, f0, o[eb], 0, 0, 0);
                            o[eb] = __builtin_amdgcn_mfma_f32_32x32x16_bf16(qbv, b0, o[eb], 0, 0, 0);
                        }
                    }
                }
                {
                    const float w0 = INP(I_RNW)[l * 256 + h * 64 + r32], w1 = INP(I_RNW)[l * 256 + h * 64 + 32 + r32];
                    bf16_t g0[16], g1[16];
#pragma unroll
                    for (int r = 0; r < 16; ++r) { const size_t row = (size_t)(rowbase + wq * 32 + crow(r, hi)); g0[r] = P[row * INW + OFF_RG + h * 64 + r32]; g1[r] = P[row * INW + OFF_RG + h * 64 + 32 + r32]; }
                    float ssv[16];
#pragma unroll
                    for (int r = 0; r < 16; ++r) ssv[r] = o[0][r] * o[0][r] + o[1][r] * o[1][r];
#pragma unroll
                    for (int st = 1; st < 32; st <<= 1)
#pragma unroll
                        for (int r = 0; r < 16; ++r) ssv[r] += shfl_xor_l(ssv[r], lane, st);
#pragma unroll
                    for (int r = 0; r < 16; ++r) {
                        const float rs = __builtin_amdgcn_rsqf(ssv[r] * (1.0f / 64.0f) + EPS);
                        const size_t row = (size_t)(rowbase + wq * 32 + crow(r, hi));
                        MIX[row * D + 768 + h * 64 + r32] = f2bf(silu_f(bf2f(g0[r])) * (o[0][r] * rs * w0));
                        MIX[row * D + 768 + h * 64 + 32 + r32] = f2bf(silu_f(bf2f(g1[r])) * (o[1][r] * rs * w1));
                    }
                }
                if (g2c && pass == 0 && rep_ == 0) { asm volatile("s_waitcnt vmcnt(0)" ::: "memory"); __syncthreads();
                    if (tid == 0) { __builtin_amdgcn_fence(__ATOMIC_RELEASE, "agent"); asm volatile("s_waitcnt vmcnt(0)" ::: "memory"); (void)xb_add(ctxcnt, 1u); } }
                __syncthreads();
            }
            __syncthreads();
            bf16_t* U = (bf16_t*)lds;
            bf16_t* DF = (bf16_t*)(lds + 45056);
            constexpr int US = 264;
            const int npool = pass == 0 ? nctx : 512;
            const bf16_t* pwt = POOLWT + (size_t)l * 4 * 4096;
            const int pg = wave >> 1, pth = wave & 1, pfr = lane & 15, pfq = lane >> 4;
            bf16x8 bfv[2][4]; f32x4 psv[4];
#pragma unroll
            for (int ks = 0; ks < 2; ++ks)
#pragma unroll
                for (int n = 0; n < 4; ++n) bfv[ks][n] = *(const bf16x8*)(pwt + (size_t)pg * 4096 + (16 * n + pfr) * 64 + 32 * ks + 8 * pfq);
#pragma unroll
            for (int n = 0; n < 4; ++n) psv[n] = *(const f32x4*)(INP(I_POOLS) + l * 256 + pg * 64 + 16 * n + 4 * pfq);
            bf16x8 uv[5] = {};
#define POOL_DEC(it_, b_, s0_, t0_, Ls_) do { if (pass == 1) { b_ = (it_) >> 6; t0_ = ((it_) & 63) * 64; s0_ = b_ * LT + LC; Ls_ = L; } else { b_ = (it_) >> 2; t0_ = ((it_) & 3) * 64; s0_ = b_ * LT; Ls_ = LC; } } while (0)
#define POOL_LOAD(it_) do { int b_, s0_, t0_, Ls_; POOL_DEC(it_, b_, s0_, t0_, Ls_); (void)b_; _Pragma("unroll") for (int i = 0; i < 5; ++i) { const int t = t0_ - 8 + (tid >> 5) + 16 * i; \
                bf16x8 v = {0, 0, 0, 0, 0, 0, 0, 0}; if (t >= 0 && t < Ls_) v = *(const bf16x8*)(P + (size_t)(s0_ + t) * INW + OFF_PU + (tid & 31) * 8); uv[i] = v; } } while (0)
            int it = pass == 0 ? (vcu + GW - 32) % GW : (vcu + GW - 128) % GW;
            if (it < npool) POOL_LOAD(it);
            for (; it < npool; it += GW) {
                int b, s0, t0, Ls; POOL_DEC(it, b, s0, t0, Ls); (void)b;
#pragma unroll
                for (int i = 0; i < 5; ++i) *(bf16x8*)(U + ((tid >> 5) + 16 * i) * US + (tid & 31) * 8) = uv[i];
                __syncthreads();
                if (it + GW < npool) POOL_LOAD(it + GW);
#pragma unroll 1
                for (int g = 0; g < 4; ++g) { const int tt = tid >> 3, c8 = g * 64 + (tid & 7) * 8, hw = 1 << g;
                    const int t = t0 + tt; int lo = t - hw; lo = lo < 0 ? 0 : lo; int hi2 = t + hw; hi2 = hi2 > Ls ? Ls : hi2;
                    float s[8] = {0.f, 0.f, 0.f, 0.f, 0.f, 0.f, 0.f, 0.f};
                    for (int q = lo; q < hi2; ++q) { const bf16x8 v = *(const bf16x8*)(U + (q - t0 + 8) * US + c8);
#pragma unroll
                        for (int z = 0; z < 8; ++z) s[z] += bf2f((bf16_t)v[z]); }
                    const float inv = 1.0f / (float)(hi2 - lo);
                    const bf16x8 me = *(const bf16x8*)(U + (tt + 8) * US + c8);
                    u32x4 o; float dv[8];
#pragma unroll
                    for (int z = 0; z < 8; ++z) dv[z] = s[z] * inv - bf2f((bf16_t)me[z]);
                    o.x = cvt_pk_bf16(dv[0], dv[1]); o.y = cvt_pk_bf16(dv[2], dv[3]); o.z = cvt_pk_bf16(dv[4], dv[5]); o.w = cvt_pk_bf16(dv[6], dv[7]);
                    *(u32x4*)(DF + tt * US + c8) = o; }
                __syncthreads();
                {
                    f32x4 acc[2][4];
#pragma unroll
                    for (int m = 0; m < 2; ++m)
#pragma unroll
                        for (int n = 0; n < 4; ++n) acc[m][n] = (f32x4){0.f, 0.f, 0.f, 0.f};
#pragma unroll
                    for (int ks = 0; ks < 2; ++ks) {
                        bf16x8 af[2];
#pragma unroll
                        for (int m = 0; m < 2; ++m) af[m] = *(const bf16x8*)(DF + (32 * pth + 16 * m + pfr) * US + pg * 64 + 32 * ks + 8 * pfq);
#pragma unroll
                        for (int m = 0; m < 2; ++m)
#pragma unroll
                            for (int n = 0; n < 4; ++n) acc[m][n] = __builtin_amdgcn_mfma_f32_16x16x32_bf16(bfv[ks][n], af[m], acc[m][n], 0, 0, 0);
                    }
#pragma unroll
                    for (int m = 0; m < 2; ++m)
#pragma unroll
                        for (int n = 0; n < 4; ++n) {
                            const int jc = pg * 64 + 16 * n + 4 * pfq;
                            const f32x4 r = acc[m][n] * psv[n];
                            u32x2 o; o.x = cvt_pk_bf16(r[0], r[1]); o.y = cvt_pk_bf16(r[2], r[3]);
                            *(u32x2*)(MIX + (size_t)(s0 + t0 + 32 * pth + 16 * m + pfr) * D + 512 + jc) = o;
                        }
                }
                if (g2c && pass == 0 && rep_ == 0) { asm volatile("s_waitcnt vmcnt(0)" ::: "memory"); __syncthreads();
                    if (tid == 0) { __builtin_amdgcn_fence(__ATOMIC_RELEASE, "agent"); asm volatile("s_waitcnt vmcnt(0)" ::: "memory"); (void)xb_add(ctxcnt, 1u); } }
                __syncthreads();
            }
#undef POOL_DEC
#undef POOL_LOAD
            __syncthreads();
            }
        }
        GRID_BAR();
        PH(6) REP(6) { WSPTRS(); const float* modl = MODV + (size_t)l * 9 * 6144;
            pg8::DenseSched S; S.init(M, D, D, G, bx, WOUT + (size_t)l * 1024 * 1024, last || G == 256);
            pg8::EpiG2 E{INP(I_X), INP(I_CTX), XB, modl, l == 0};
            pg8::gemm_phase<pg8::EpiG2, pg8::DenseSched>(ldsl, (const char*)MIX, D, S, E, wave0);
        }
        GRID_BAR();
        PH(7) REP(7) { WSPTRS(); const float* modl = MODV + (size_t)l * 9 * 6144;
            float* RWE = (float*)lds;
            float* PART = (float*)(lds_all + LC_PART);
            int* RI = (int*)(lds_all + LC_RI);
            float* RGt = (float*)(lds_all + LC_RG);
            volatile LAS int* lcnt = (volatile LAS int*)(ldsc + LC_LCNT);
            volatile LAS int* lbase = (volatile LAS int*)(ldsc + LC_BASE);
            const float* nw = INP(I_N2W) + l * D; const float* rwp = INP(I_RW); const float* rbp = INP(I_RB);
            for (int vb = vcu; vb < 256; vb += G) {
                const int b = vb >> 5, q = vb & 31; int row0, nrows; bool isctx = false;
                if (last) { row0 = b * LT + LC + q * 128; nrows = 128; }
                else if (q < 2) { isctx = true; row0 = b * LT + q * 128; nrows = 128; }
                else { row0 = b * LT + LC + (q - 2) * 137; nrows = L - (q - 2) * 137; nrows = nrows > 137 ? 137 : nrows; }
                const float* mod = modl + (size_t)(isctx ? 8 : b) * 6144;
                f32x4 wsc[4], shv[4];
#pragma unroll
                for (int jj = 0; jj < 4; ++jj) { const int cc = 4 * lane + 256 * jj; wsc[jj] = *(const f32x4*)(nw + cc) * (*(const f32x4*)(mod + 4096 + cc) + 1.0f); shv[jj] = *(const f32x4*)(mod + 3072 + cc); }
                if (tid < 16) lcnt[tid] = 0;
                float bp[16];
#pragma unroll
                for (int e = 0; e < 16; ++e) bp[e] = 0.f;
#pragma unroll
                for (int hh = 0; hh < 2; ++hh) {
                    const int k = tid + 512 * hh;
                    const float wk = nw[k] * (mod[4096 + k] + 1.0f), shk = mod[3072 + k];
                    float* dstp = RWE + (size_t)(((k >> 2) & 63) + 64 * ((k & 3) + 4 * (k >> 8))) * 20;
#pragma unroll
                    for (int e4 = 0; e4 < 4; ++e4) { const f32x4 r = *(const f32x4*)(rwp + k * 16 + 4 * e4); *(f32x4*)(dstp + 4 * e4) = r * wk;
                        bp[4 * e4 + 0] += shk * r[0]; bp[4 * e4 + 1] += shk * r[1]; bp[4 * e4 + 2] += shk * r[2]; bp[4 * e4 + 3] += shk * r[3]; }
                }
#pragma unroll
                for (int e = 0; e < 16; ++e) { const float t = wave_sum(bp[e], lane); if (lane == 0) PART[wave * 16 + e] = t; }
                __syncthreads();
                float rbv[16]; float lgb_lane = 0.f;
#pragma unroll
                for (int w = 0; w < 8; ++w) lgb_lane += PART[w * 16 + ((lane >> 2) & 15)];
#pragma unroll
                for (int e = 0; e < 16; ++e) rbv[e] = __int_as_float(__builtin_amdgcn_readfirstlane(__float_as_int(rbp[e])));
                float* LGS = (float*)(lds + 81920) + wave * (18 * 16);
                const bf16_t* xbase = XB + (size_t)row0 * D;
                f32x4 xv[4] = {};
                if (wave < nrows) {
#pragma unroll
                    for (int jj = 0; jj < 4; ++jj) xv[jj] = bf4_to_f4(*(const u32x2*)(xbase + (size_t)wave * D + 4 * lane + 256 * jj));
                }
                for (int rr = wave; rr < nrows; rr += 8) {
                    f32x4 xn[4] = {};
                    if (rr + 8 < nrows) {
#pragma unroll
                        for (int jj = 0; jj < 4; ++jj) xn[jj] = bf4_to_f4(*(const u32x2*)(xbase + (size_t)(rr + 8) * D + 4 * lane + 256 * jj));
                    }
                    float ss = 0.f; f32x2 d2[8];
#pragma unroll
                    for (int e = 0; e < 8; ++e) d2[e] = (f32x2){0.f, 0.f};
#pragma unroll
                    for (int jj = 0; jj < 4; ++jj) {
                        ss += (xv[jj][0] * xv[jj][0] + xv[jj][1] * xv[jj][1]) + (xv[jj][2] * xv[jj][2] + xv[jj][3] * xv[jj][3]);
                        f32x4 rr4[4][4];
#pragma unroll
                        for (int i = 0; i < 4; ++i) { const float* rw = RWE + (size_t)(lane + 64 * (i + 4 * jj)) * 20;
#pragma unroll
                            for (int q4 = 0; q4 < 4; ++q4) rr4[i][q4] = *(const f32x4*)(rw + 4 * q4); }
#pragma unroll
                        for (int i = 0; i < 4; ++i) { const f32x2 xk2 = (f32x2){xv[jj][i], xv[jj][i]};
#pragma unroll
                            for (int q4 = 0; q4 < 4; ++q4) { d2[2 * q4] = __builtin_elementwise_fma((f32x2){rr4[i][q4][0], rr4[i][q4][1]}, xk2, d2[2 * q4]); d2[2 * q4 + 1] = __builtin_elementwise_fma((f32x2){rr4[i][q4][2], rr4[i][q4][3]}, xk2, d2[2 * q4 + 1]); } }
                        __builtin_amdgcn_sched_barrier(0);
                    }
                    float dot[16];
#pragma unroll
                    for (int e = 0; e < 8; ++e) { dot[2 * e] = d2[e][0]; dot[2 * e + 1] = d2[e][1]; }
                    ss = wave_sum(ss, lane);
                    float t8[8], t4[4], t2[2], dv;
#pragma unroll
                    for (int i = 0; i < 8; ++i) { auto rr2 = __builtin_amdgcn_permlane32_swap(__float_as_uint(dot[i]), __float_as_uint(dot[i + 8]), false, false); t8[i] = __uint_as_float(rr2[0]) + __uint_as_float(rr2[1]); }
                    { const bool b4 = (lane & 16) != 0, b3 = (lane & 8) != 0, b2 = (lane & 4) != 0;
#pragma unroll
                      for (int i = 0; i < 4; ++i) { const float keep = b4 ? t8[i + 4] : t8[i], send = b4 ? t8[i] : t8[i + 4]; t4[i] = keep + shfl_xor_l(send, lane, 16); }
#pragma unroll
                      for (int i = 0; i < 2; ++i) { const float keep = b3 ? t4[i + 2] : t4[i], send = b3 ? t4[i] : t4[i + 2]; t2[i] = keep + shfl_xor_l(send, lane, 8); }
                      { const float keep = b2 ? t2[1] : t2[0], send = b2 ? t2[0] : t2[1]; dv = keep + shfl_xor_l(send, lane, 4); }
                      dv += shfl_xor_l(dv, lane, 2); dv += shfl_xor_l(dv, lane, 1); }
                    const float rstd = __builtin_amdgcn_rsqf(ss * (1.0f / D) + EPS);
                    const int row = row0 + rr;
#pragma unroll
                    for (int jj = 0; jj < 4; ++jj) {
                        const f32x4 hv = xv[jj] * rstd * wsc[jj] + shv[jj];
                        *(unsigned*)(H8 + (size_t)row * D + 4 * lane + 256 * jj) = pk4_fp8(hv[0], hv[1], hv[2], hv[3]);
                    }
                    if ((lane & 3) == 0) LGS[(rr >> 3) * 16 + (lane >> 2)] = dv * rstd + lgb_lane;
#pragma unroll
                    for (int jj = 0; jj < 4; ++jj) xv[jj] = xn[jj];
                }
                asm volatile("s_waitcnt lgkmcnt(0)" ::: "memory");
                {
                    const int rr = wave + 8 * lane;
                    if (rr < nrows) {
                        float sg[16], sel[16];
#pragma unroll
                        for (int e4 = 0; e4 < 4; ++e4) { const f32x4 lg4 = *(const f32x4*)(LGS + lane * 16 + 4 * e4);
#pragma unroll
                            for (int q4 = 0; q4 < 4; ++q4) { const int e = 4 * e4 + q4; sg[e] = __builtin_amdgcn_rcpf(1.0f + __builtin_amdgcn_exp2f(-lg4[q4] * LOG2E)); sel[e] = sg[e] + rbv[e]; } }
                        float best = -1e30f; int gi = 0;
#pragma unroll
                        for (int g = 0; g < 4; ++g) {
                            float m1 = -1e30f, m2 = -1e30f;
#pragma unroll
                            for (int qq = 0; qq < 4; ++qq) { const float x_ = sel[4 * g + qq]; if (x_ > m1) { m2 = m1; m1 = x_; } else if (x_ > m2) m2 = x_; }
                            const float gs = m1 + m2; if (gs > best) { best = gs; gi = g; }
                        }
                        float v1 = -1e30f, v2 = -1e30f; int i1 = 0, i2 = 0; float sa = 0.f, sb2 = 0.f;
#pragma unroll
                        for (int g = 0; g < 4; ++g)
#pragma unroll
                            for (int qq = 0; qq < 4; ++qq) if (g == gi) {
                                const float x_ = sel[4 * g + qq], sx = sg[4 * g + qq];
                                if (x_ > v1) { v2 = v1; i2 = i1; sb2 = sa; v1 = x_; i1 = 4 * g + qq; sa = sx; } else if (x_ > v2) { v2 = x_; i2 = 4 * g + qq; sb2 = sx; }
                            }
                        const float rden = 1.0f / (sa + sb2);
                        const int p0 = __hip_atomic_fetch_add((LAS int*)&lcnt[i1], 1, __ATOMIC_RELAXED, __HIP_MEMORY_SCOPE_WORKGROUP), p1 = __hip_atomic_fetch_add((LAS int*)&lcnt[i2], 1, __ATOMIC_RELAXED, __HIP_MEMORY_SCOPE_WORKGROUP);
                        RI[rr * 4 + 0] = i1; RI[rr * 4 + 1] = i2; RI[rr * 4 + 2] = p0; RI[rr * 4 + 3] = p1; RGt[rr * 2] = sa * rden; RGt[rr * 2 + 1] = sb2 * rden;
                    }
                }
                __syncthreads();
                if (tid < 16) { const int n = lcnt[tid]; lbase[tid] = n ? (int)__hip_atomic_fetch_add(ctl + CW_CNT + (l * 16 + tid) * 64, (unsigned)n, __ATOMIC_RELAXED, __HIP_MEMORY_SCOPE_AGENT) : 0; }
                __syncthreads();
                for (int qq = tid; qq < nrows * 2; qq += 512) {
                    const int rr = qq >> 1, k = qq & 1, row = row0 + rr;
                    const int e = RI[rr * 4 + k]; const int pos = lbase[e] + RI[rr * 4 + 2 + k]; const int pair = row * 2 + k; TOK[(size_t)e * CAP + pos] = pair; GATE[pair] = RGt[rr * 2 + k];
                }
                __syncthreads();
            }
        }
        GRID_BAR();
        PH(8) REP(8) { WSPTRS();
            volatile LAS int* tp = (volatile LAS int*)(ldsc + LC_TP);
            volatile LAS int* cn = (volatile LAS int*)(ldsc + LC_CNT);
            if (tid == 0) { int acc_ = 0; for (int e = 0; e < 16; ++e) { const int n = (int)__hip_atomic_load(ctl + CW_CNT + (l * 16 + e) * 64, __ATOMIC_RELAXED, __HIP_MEMORY_SCOPE_AGENT); cn[e] = n; tp[e] = acc_; acc_ += (n + 255) >> 8; } tp[16] = acc_; }
            __syncthreads();
            {
                pg8::MoeSched<true> S{G, bx, NGU / 256, D, (const char*)(WGU + (size_t)l * 16 * NGU * 1024), (size_t)NGU * 1024, (const LAS int*)tp, (const LAS int*)cn, TOK};
                pg8::EpiE1 E{ACT};
                pg8::gemm_phase<pg8::EpiE1, pg8::MoeSched<true>, true>(ldsl, (const char*)H8, D, S, E, wave0);
            }
            GRID_BAR();
            {
                pg8::MoeSched<false> S{G, bx, D / 256, DE, (const char*)(WDN + (size_t)l * 16 * 1024 * DE), (size_t)1024 * DE, (const LAS int*)tp, (const LAS int*)cn, TOK};
                pg8::EpiE2 E{Y2, TOK, GATE, (const LAS int*)cn};
                pg8::gemm_phase<pg8::EpiE2, pg8::MoeSched<false>, true>(ldsl, (const char*)ACT, DE, S, E, wave0);
            }
        }
        GRID_BAR();
    }
    PH(9) REP(9) { WSPTRS();
        const float* g2b = MODV + (size_t)3 * 9 * 6144 + 5 * 1024;
        for (int r = gw; r < NB * L; r += NGW) {
            const int b = r / L, t = r - b * L; const int row = b * LT + LC + t;
            float* xr = OUT + (size_t)r * D;
            const float* g2 = g2b + (size_t)b * 6144;
            const unsigned char* y0 = Y2 + (size_t)(2 * row) * D; const unsigned char* y1 = y0 + D;
            f32x4 v[4]; float ss = 0.f;
#pragma unroll
            for (int jj = 0; jj < 4; ++jj) {
                const int cc = 4 * lane + 256 * jj;
                const f32x4 a = fp8x4_to_f4(*(const unsigned*)(y0 + cc)), bb = fp8x4_to_f4(*(const unsigned*)(y1 + cc)), g = *(const f32x4*)(g2 + cc) * pg8::YINV;
                v[jj] = bf4_to_f4(*(const u32x2*)(XB + (size_t)row * D + cc)) + g * (a + bb);
                ss += (v[jj][0] * v[jj][0] + v[jj][1] * v[jj][1]) + (v[jj][2] * v[jj][2] + v[jj][3] * v[jj][3]);
            }
            ss = wave_sum(ss, lane);
            const float rstd = 1.0f / sqrtf(ss * (1.0f / D) + EPS);
#pragma unroll
            for (int jj = 0; jj < 4; ++jj) { const int cc = 4 * lane + 256 * jj; *(f32x4*)(xr + cc) = v[jj] * rstd * *(const f32x4*)(INP(I_FNW) + cc); }
        }
    }
}

extern "C" void kernel_launch(void* const* d_in, const int* in_sizes, int n_in, void* d_out, int out_size, void* d_ws, size_t ws_size, hipStream_t stream) {
    static int grid = 0;
    if (grid == 0) {
        if (n_in != 23 || out_size != NB * L * D || ws_size < WS_END) { fprintf(stderr, "kernel_launch: unexpected shapes (n_in %d out %d ws %zu, need ws >= %zu)\n", n_in, out_size, ws_size, (size_t)WS_END); grid = -1; return; }
        int dev = 0, cus = 0, per_cu = 0;
        if (hipGetDevice(&dev) != hipSuccess || hipDeviceGetAttribute(&cus, hipDeviceAttributeMultiprocessorCount, dev) != hipSuccess) { grid = -1; return; }
        if (hipFuncSetAttribute((const void*)fwd_kernel, hipFuncAttributeMaxDynamicSharedMemorySize, LDS_BYTES) != hipSuccess) { fprintf(stderr, "kernel_launch: hipFuncSetAttribute failed\n"); grid = -1; return; }
        if (hipOccupancyMaxActiveBlocksPerMultiprocessor(&per_cu, (const void*)fwd_kernel, 512, LDS_BYTES) != hipSuccess || per_cu < 1) fprintf(stderr, "kernel_launch: occupancy query reports %d\n", per_cu);
        (void)hipGetLastError();
        grid = cus;
    }
    if (grid < 0) return;
    (void)hipMemsetAsync((char*)d_ws + WS_CTL, 0, CTL_ZERO_BYTES, stream);
    Params p{};
    const float** pp = (const float**)&p;
    for (int i = 0; i < 23; ++i) pp[i] = (const float*)d_in[i];
    p.out = (float*)d_out; p.ws = (unsigned char*)d_ws;
    hipLaunchKernelGGL(fwd_kernel, dim3(grid), dim3(512), LDS_BYTES, stream, p);
    const hipError_t le = hipPeekAtLastError();
    if (le != hipSuccess) fprintf(stderr, "kernel_launch: launch failed: %s\n", hipGetErrorName(le));
}
```

```cpp
#include <hip/hip_runtime.h>
#include <cstdio>
#include <cstdint>

#define LAS __attribute__((address_space(3)))
#define GAS __attribute__((address_space(1)))
typedef unsigned short bf16_t;
typedef short bf16x8 __attribute__((ext_vector_type(8)));
typedef short s16x4 __attribute__((ext_vector_type(4)));
typedef float f32x2 __attribute__((ext_vector_type(2)));
typedef float f32x4 __attribute__((ext_vector_type(4)));
typedef float f32x16 __attribute__((ext_vector_type(16)));
typedef unsigned u32x2 __attribute__((ext_vector_type(2)));
typedef unsigned u32x4 __attribute__((ext_vector_type(4)));

constexpr int D = 1024, NB = 8, L = 4096, LC = 256, LT = L + LC, M = NB * LT;
constexpr int DEPTH = 4, INW = 2816;
constexpr int OFF_DQ = 0, OFF_DK = 512, OFF_DV = 1024, OFF_PU = 1536, OFF_RQ = 1792, OFF_RK = 2048, OFF_RV = 2304, OFF_RG = 2560;
constexpr int NE = 16, DE = 768, NGU = 2 * DE;
constexpr int NCH = LT / 128;
constexpr int CAP = M;
constexpr int ACT_ROWS = 73728;
constexpr float EPS = 1e-6f;
constexpr float LOG2E = 1.4426950408889634f;

constexpr size_t MiB = 1u << 20;
constexpr size_t WS_CTL = 0, CTL_ZERO_BYTES = 1 * MiB;
constexpr size_t WS_MOD = 1 * MiB;
constexpr size_t WS_ROPE = 2 * MiB;
constexpr size_t WS_POOLW = 2 * MiB + 16384;
constexpr size_t WS_GATE = 3 * MiB;
constexpr size_t WS_TOK = 4 * MiB;
constexpr size_t WS_XC = 8 * MiB;
constexpr size_t WS_KV = 16 * MiB;
constexpr size_t WS_ST = 50 * MiB;
constexpr size_t WS_WIN = 68 * MiB;
constexpr size_t WS_WOUT = 90 * MiB;
constexpr size_t WS_WGU = 98 * MiB;
constexpr size_t WS_WDN = 194 * MiB;
constexpr size_t WS_H8 = 242 * MiB;
constexpr size_t WS_QK8 = 276 * MiB;
constexpr size_t WS_VT8 = 312 * MiB;
constexpr size_t WS_H = 330 * MiB;
constexpr size_t WS_XB = 386 * MiB;
constexpr size_t WS_P = 454 * MiB;
constexpr size_t WS_MIX = 641 * MiB;
constexpr size_t WS_ACT = WS_P;
constexpr size_t WS_Y2 = 562 * MiB;
constexpr size_t WS_K8T = 709 * MiB;
constexpr size_t WS_END = 727 * MiB;
constexpr size_t K8T_OFF = WS_K8T - WS_QK8;
static_assert(WS_ACT + (size_t)ACT_ROWS * DE * 2 <= WS_Y2 && WS_Y2 + (size_t)2 * M * D * 2 <= WS_END, "ws map");
static_assert(WS_P + (size_t)M * INW * 2 <= WS_MIX && WS_MIX + (size_t)M * D * 2 <= WS_END, "ws map");
constexpr int CW_TMO = 0;
constexpr int CW_BAR = 4096;
constexpr int CW_CTX = 8192;
constexpr int CW_CNT = 16384;

constexpr int RING_BYTES = 131072;
constexpr int LDSCTL_OFF = 0, LDSCTL_BYTES = 8192, RING_OFF = LDSCTL_BYTES;
constexpr int LDS_BYTES = 147456;
constexpr int LC_BARW = 0;
constexpr int LC_TP = 64;
constexpr int LC_CNT = 160;
constexpr int LC_LCNT = 256;
constexpr int LC_BASE = 320;
constexpr int LC_PTR = 512;
constexpr int LC_PART = 1024;
constexpr int LC_RG = 1536;
constexpr int LC_RI = 3072;

__device__ __forceinline__ int opaque_int(int v) { asm volatile("" : "+s"(v)); return v; }
__device__ __forceinline__ int opaque_tid(int wave0) { int w = wave0; asm volatile("" : "+s"(w)); int t; asm volatile("v_mbcnt_lo_u32_b32 %0, -1, 0\n\tv_mbcnt_hi_u32_b32 %0, -1, %0" : "=&v"(t)); return t + (w << 6); }
__device__ __forceinline__ float bf2f(bf16_t v) { return __uint_as_float(((unsigned)v) << 16); }
__device__ __forceinline__ unsigned cvt_pk_bf16(float lo, float hi) { unsigned r; asm volatile("v_cvt_pk_bf16_f32 %0, %1, %2" : "=v"(r) : "v"(lo), "v"(hi)); return r; }
__device__ __forceinline__ bf16_t f2bf(float f) { return (bf16_t)(cvt_pk_bf16(f, 0.f) & 0xffffu); }
__device__ __forceinline__ float shfl_xor_l(float v, int lane, int o) { return __int_as_float(__builtin_amdgcn_ds_bpermute((lane ^ o) << 2, __float_as_int(v))); }
__device__ __forceinline__ float wave_sum(float v, int lane) {
#pragma unroll
    for (int o = 1; o < 64; o <<= 1) v += shfl_xor_l(v, lane, o);
    return v;
}
__device__ __forceinline__ float half_sum32(float v, int lane) {
#pragma unroll
    for (int o = 1; o < 32; o <<= 1) v += shfl_xor_l(v, lane, o);
    return v;
}
__device__ __forceinline__ unsigned pk4_fp8(float a, float b, float c, float d) { int w = 0; w = __builtin_amdgcn_cvt_pk_fp8_f32(a, b, w, false); w = __builtin_amdgcn_cvt_pk_fp8_f32(c, d, w, true); return (unsigned)w; }
__device__ __forceinline__ f32x4 fp8x4_to_f4(unsigned w) { const f32x2 lo = __builtin_amdgcn_cvt_pk_f32_fp8((int)w, false), hi = __builtin_amdgcn_cvt_pk_f32_fp8((int)w, true); return (f32x4){lo[0], lo[1], hi[0], hi[1]}; }
__device__ __forceinline__ float silu_f(float g) { return g * __builtin_amdgcn_rcpf(1.0f + __builtin_amdgcn_exp2f(-g * LOG2E)); }
__device__ __forceinline__ f32x4 bf4_to_f4(u32x2 a) { f32x4 r; r[0] = __uint_as_float(a.x << 16); r[1] = __uint_as_float(a.x & 0xffff0000u); r[2] = __uint_as_float(a.y << 16); r[3] = __uint_as_float(a.y & 0xffff0000u); return r; }

#define XB_TMO      128
#define XB_XCNT(j)  (256  + 64 * (j))
#define XB_XSUB(j)  (1280 + 64 * (j))
#define XB_XGEN(j)  (2304 + 64 * (j))
#define XB_TOP      3328
#define XB_TOPGEN   3392
#define XCD_BAR_WORDS 3456
#define XB_SPIN_CAP (1u << 18)
__device__ __forceinline__ unsigned xb_ld(unsigned* p)              { return __hip_atomic_load(p, __ATOMIC_RELAXED, __HIP_MEMORY_SCOPE_AGENT); }
__device__ __forceinline__ unsigned xb_add(unsigned* p, unsigned v) { return __hip_atomic_fetch_add(p, v, __ATOMIC_RELAXED, __HIP_MEMORY_SCOPE_AGENT); }
__device__ __forceinline__ unsigned xb_xcc_id() { return (unsigned)__builtin_amdgcn_s_getreg((3 << 11) | 20) & 0xFu; }
#define XB_SPIN(cond, bar) do { unsigned _sp = 0; while (cond) { __builtin_amdgcn_s_sleep(1); \
    if ((++_sp & 255u) == 0u) { if (xb_ld(&(bar)[XB_TMO])) break; if (_sp > XB_SPIN_CAP) { atomicAdd(&(bar)[XB_TMO], 1u); break; } } } } while (0)
struct XcdBarrier { unsigned* bar; unsigned x; volatile LAS unsigned* st; };
__device__ __forceinline__ XcdBarrier xcd_barrier_post(unsigned* bar, volatile LAS unsigned* st) {
    XcdBarrier b; b.bar = bar; b.x = xb_xcc_id(); b.st = st;
    if (threadIdx.x == 0) (void)xb_add(&bar[XB_XCNT(b.x)], 1u);
    return b;
}
__device__ __forceinline__ void xcd_barrier_complete(unsigned* bar, unsigned x, unsigned& nloc, unsigned& nx) {
    const unsigned G = gridDim.x * gridDim.y * gridDim.z;
    unsigned sum, cnt, mine, sp = 0u;
    for (;;) {
        sum = 0u; cnt = 0u; mine = 0u;
#pragma unroll
        for (unsigned j = 0; j < 16; ++j) { const unsigned c = xb_ld(&bar[XB_XCNT(j)]); sum += c; cnt += (c > 0u) ? 1u : 0u; mine = (j == x) ? c : mine; }
        if (sum == G) break;
        __builtin_amdgcn_s_sleep(1);
        if ((++sp & 255u) == 0u) { if (xb_ld(&bar[XB_TMO])) break; if (sp > XB_SPIN_CAP) { atomicAdd(&bar[XB_TMO], 1u); break; } }
    }
    nloc = mine > 0u ? mine : 1u; nx = cnt > 0u ? cnt : 1u;
}
__device__ __forceinline__ void xcd_barrier(const XcdBarrier& b) {
    asm volatile("s_waitcnt vmcnt(0)" ::: "memory");
    __syncthreads();
    if (threadIdx.x == 0) {
        unsigned long long bv_ = (unsigned long long)b.bar; unsigned bx_ = b.x;
        asm volatile("" : "+s"(bv_), "+s"(bx_));
        unsigned* bar = (unsigned*)(GAS unsigned*)bv_;
        __builtin_amdgcn_s_waitcnt(0);
        unsigned nloc = b.st[0], nx = b.st[1];
        if (nloc == 0u) { xcd_barrier_complete(bar, bx_, nloc, nx); b.st[0] = nloc; b.st[1] = nx; }
        const unsigned old = xb_add(&bar[XB_XSUB(bx_)], 1u);
        const unsigned gen = old / nloc;
        if (old + 1u == (gen + 1u) * nloc) {
            __builtin_amdgcn_fence(__ATOMIC_RELEASE, "agent");
            asm volatile("s_waitcnt vmcnt(0)" ::: "memory");
            const unsigned og = xb_add(&bar[XB_TOP], 1u);
            const unsigned tg = og / nx;
            if (og + 1u == (tg + 1u) * nx) xb_add(&bar[XB_TOPGEN], 1u);
            else XB_SPIN(xb_ld(&bar[XB_TOPGEN]) == tg, bar);
            __builtin_amdgcn_fence(__ATOMIC_ACQUIRE, "agent");
            xb_add(&bar[XB_XGEN(bx_)], 1u);
            asm volatile("s_waitcnt vmcnt(0)" ::: "memory");
        } else {
            XB_SPIN(xb_ld(&bar[XB_XGEN(bx_)]) == gen, bar);
            __builtin_amdgcn_fence(__ATOMIC_ACQUIRE, "agent");
            asm volatile("s_waitcnt vmcnt(0)" ::: "memory");
        }
    }
    __syncthreads();
}

namespace pg8 {
constexpr int BM = 256, BK = 64, HALF = 128, HTB = HALF * BK * 2, STAGE_BYTES = 8 * HTB;
__host__ __device__ __forceinline__ int lds_byte(int r, int c) { const int st = (r >> 4) * 2 + (c >> 5), rr = r & 15, cc = c & 31, ob = rr * 64 + cc * 2; return st * 1024 + (ob ^ (((ob >> 9) & 1) << 5)); }
__host__ __device__ __forceinline__ void stage_rc(int b, int& R, int& C) { const int st = b / 1024, sb = b % 1024, swz = sb ^ (((sb >> 9) & 1) << 5); R = (st >> 1) * 16 + swz / 64; C = (st & 1) * 32 + (swz % 64) / 2; }
__host__ __device__ __forceinline__ int perm32(int rho) { const int n = rho >> 4, i = rho & 15; return 8 * (i >> 2) + 4 * n + (i & 3); }
struct Unit { int pm, pn, e, rt; };
typedef int v8i32 __attribute__((ext_vector_type(8)));
typedef int v4i32 __attribute__((ext_vector_type(4)));
__device__ __forceinline__ v8i32 cat8(bf16x8 a, bf16x8 b) { const v4i32 x = __builtin_bit_cast(v4i32, a), y = __builtin_bit_cast(v4i32, b); return __builtin_shufflevector(x, y, 0, 1, 2, 3, 4, 5, 6, 7); }

template <class Epi, class Sched, bool FP8 = false>
__device__ __forceinline__ void gemm_phase(LAS unsigned char* lds, const char* Abase, const int K, const Sched& S, const Epi& E, const int wave0) {
    const int tid = opaque_tid(wave0), wid = __builtin_amdgcn_readfirstlane(tid >> 6), lane = tid & 63, wr = wid >> 2, wc = wid & 3, fr = lane & 15, fq = lane >> 4;
    const int rowB = FP8 ? K : 2 * K;
    const int nt = rowB / (BK * 2);
    int RA[2], CA[2]; unsigned voffB[2];
#pragma unroll
    for (int i = 0; i < 2; ++i) { int R, C; stage_rc(tid * 16 + i * 8192, R, C); const int Rb = (R & ~31) + perm32(R & 31); RA[i] = R; CA[i] = C; voffB[i] = (unsigned)(Rb * rowB + C * 2); }
    const size_t kstep = (size_t)(BK * 2);
    const size_t hstep = (size_t)HALF * rowB;
    const unsigned ldsw = (unsigned)wid * 1024u;
    const int aoff = lds_byte(wr * 64 + fr, fq * 8), boff = lds_byte(wc * 32 + fr, fq * 8);
#define PG8_SA(b, h) (((b) * 2 + (h)) * HTB)
#define PG8_SB(b, h) ((4 + (b) * 2 + (h)) * HTB)
#define PG8_STAGE_B(bufoff, gbase) do { _Pragma("unroll") for (int _i = 0; _i < 2; ++_i) \
        __builtin_amdgcn_global_load_lds((const unsigned*)((const char*)(gbase) + voffB[_i]), (LAS unsigned*)(lds + (bufoff) + ldsw + _i * 8192), 16, 0, 0); } while (0)
#define PG8_STAGE_A(bufoff, offs, kb) do { _Pragma("unroll") for (int _i = 0; _i < 2; ++_i) \
        __builtin_amdgcn_global_load_lds((const unsigned*)((Abase + (size_t)(unsigned)(kb)) + (offs)[_i]), (LAS unsigned*)(lds + (bufoff) + ldsw + _i * 8192), 16, 0, 0); } while (0)
#define PG8_LDA(dst, b, h) do { if constexpr (FP8) { _Pragma("unroll") for (int m = 0; m < 4; ++m) dst##8[m] = __builtin_shufflevector(*(const LAS v4i32*)(lds + PG8_SA(b, h) + aoff + m * 2048), *(const LAS v4i32*)(lds + PG8_SA(b, h) + aoff + m * 2048 + 1024), 0, 1, 2, 3, 4, 5, 6, 7); } \
    else { _Pragma("unroll") for (int m = 0; m < 4; ++m) _Pragma("unroll") for (int k = 0; k < 2; ++k) dst[m][k] = *(const LAS bf16x8*)(lds + PG8_SA(b, h) + aoff + m * 2048 + k * 1024); } } while (0)
#define PG8_LDB(dst, b, h) do { if constexpr (FP8) { _Pragma("unroll") for (int n = 0; n < 2; ++n) dst##8[n] = __builtin_shufflevector(*(const LAS v4i32*)(lds + PG8_SB(b, h) + boff + n * 2048), *(const LAS v4i32*)(lds + PG8_SB(b, h) + boff + n * 2048 + 1024), 0, 1, 2, 3, 4, 5, 6, 7); } \
    else { _Pragma("unroll") for (int n = 0; n < 2; ++n) _Pragma("unroll") for (int k = 0; k < 2; ++k) dst[n][k] = *(const LAS bf16x8*)(lds + PG8_SB(b, h) + boff + n * 2048 + k * 1024); } } while (0)
#define PG8_MMA(ai, bj, At, Bt) do { __builtin_amdgcn_s_setprio(1); _Pragma("unroll") for (int m = 0; m < 4; ++m) _Pragma("unroll") for (int n = 0; n < 2; ++n) { \
        if constexpr (FP8) asm volatile("v_mfma_scale_f32_16x16x128_f8f6f4 %0, %1, %2, %0, %3, %3 op_sel_hi:[0,0,0]" : "+v"(acc[ai][bj][m][n]) : "v"(Bt##8[n]), "v"(At##8[m]), "v"(sc1));   \
        else { _Pragma("unroll") for (int k = 0; k < 2; ++k) acc[ai][bj][m][n] = __builtin_amdgcn_mfma_f32_16x16x32_bf16(Bt[n][k], At[m][k], acc[ai][bj][m][n], 0, 0, 0); } } __builtin_amdgcn_s_setprio(0); } while (0)
#define PG8_WAIT_V(n) asm volatile("s_waitcnt vmcnt(" #n ")" ::: "memory")
#define PG8_WAIT_L(n) asm volatile("s_waitcnt lgkmcnt(" #n ")" ::: "memory")
#define PG8_BAR __builtin_amdgcn_s_barrier()
#define PG8_SCHED __builtin_amdgcn_sched_barrier(0)
    Unit cur, nxt; int ui = 0;
    if (!S.next(0, cur)) return;
    f32x4 acc[2][2][4][2];
#pragma unroll
    for (int a = 0; a < 2; ++a)
#pragma unroll
        for (int b = 0; b < 2; ++b)
#pragma unroll
            for (int m = 0; m < 4; ++m)
#pragma unroll
                for (int n = 0; n < 2; ++n) acc[a][b][m][n] = (f32x4){0.f, 0.f, 0.f, 0.f};
    bf16x8 At[4][2], B0[2][2], B1[2][2];
    int sc1 = 0x7F7F7F7F; asm volatile("" : "+v"(sc1));
    v8i32 At8[4], B08[2], B18[2];
    (void)At; (void)B0; (void)B1; (void)At8; (void)B08; (void)B18; (void)sc1;
    unsigned cA0[2], cA1[2], nA0[2], nA1[2];
    S.a_offs(cur, RA, CA, rowB, cA0, cA1);
    const char* cB = S.b_ptr(cur);
    PG8_STAGE_B(PG8_SB(0, 0), cB); PG8_STAGE_B(PG8_SB(0, 1), cB + hstep); PG8_STAGE_A(PG8_SA(0, 0), cA0, 0); PG8_STAGE_A(PG8_SA(0, 1), cA1, 0);
    if (wr == 1) PG8_BAR;
    PG8_WAIT_V(2); PG8_BAR;
    PG8_STAGE_B(PG8_SB(1, 0), cB + kstep); PG8_STAGE_A(PG8_SA(1, 0), cA0, kstep); PG8_STAGE_B(PG8_SB(1, 1), cB + hstep + kstep);
    PG8_WAIT_V(6); PG8_BAR;
    for (;;) {
        const bool has_next = S.next(ui + 1, nxt);
        const char* nB = cB;
        if (has_next) { S.a_offs(nxt, RA, CA, rowB, nA0, nA1); nB = S.b_ptr(nxt); }
        else { nA0[0] = cA0[0]; nA0[1] = cA0[1]; nA1[0] = cA1[0]; nA1[1] = cA1[1]; }
#pragma nounroll
        for (int t = 0; t < nt; t += 2) {
            const bool last = (t == nt - 2);
            const unsigned k1 = (unsigned)(t + 1) * (unsigned)kstep;
            unsigned o20[2], o21[2];
            o20[0] = last ? nA0[0] : cA0[0]; o20[1] = last ? nA0[1] : cA0[1]; o21[0] = last ? nA1[0] : cA1[0]; o21[1] = last ? nA1[1] : cA1[1];
            const unsigned k2 = last ? 0u : (unsigned)(t + 2) * (unsigned)kstep, k3 = k2 + (unsigned)kstep;
            const char* b2 = last ? nB : cB + (size_t)(t + 2) * kstep; const char* b3 = b2 + kstep;
            PG8_LDB(B0, 0, 0); PG8_LDB(B1, 0, 1); PG8_SCHED; PG8_LDA(At, 0, 0); PG8_STAGE_A(PG8_SA(1, 1), cA1, k1);
            PG8_WAIT_V(8); PG8_WAIT_L(0); PG8_BAR; PG8_MMA(0, 0, At, B0); PG8_MMA(0, 1, At, B1); PG8_BAR; PG8_SCHED;
            PG8_LDA(At, 0, 1); PG8_STAGE_B(PG8_SB(0, 0), b2); PG8_STAGE_B(PG8_SB(0, 1), b2 + hstep); PG8_STAGE_A(PG8_SA(0, 0), o20, k2);
            PG8_WAIT_V(8); PG8_WAIT_L(0); PG8_BAR; PG8_MMA(1, 0, At, B0); PG8_MMA(1, 1, At, B1); PG8_BAR; PG8_SCHED;
            PG8_LDB(B0, 1, 0); PG8_LDB(B1, 1, 1); PG8_SCHED; PG8_LDA(At, 1, 0); PG8_STAGE_A(PG8_SA(0, 1), o21, k2);
            PG8_WAIT_V(8); PG8_WAIT_L(0); PG8_BAR; PG8_MMA(0, 0, At, B0); PG8_MMA(0, 1, At, B1); PG8_BAR; PG8_SCHED;
            PG8_LDA(At, 1, 1); PG8_STAGE_B(PG8_SB(1, 0), b3); PG8_STAGE_B(PG8_SB(1, 1), b3 + hstep); PG8_STAGE_A(PG8_SA(1, 0), o20, k3);
            PG8_WAIT_V(8); PG8_WAIT_L(0); PG8_BAR; PG8_MMA(1, 0, At, B0); PG8_MMA(1, 1, At, B1); PG8_BAR; PG8_SCHED;
        }
        if (wr == 0) PG8_BAR;
        if constexpr (FP8) asm volatile("s_nop 15\n\ts_nop 15" ::: "memory");
        E(acc, cur, wr, wc, fr, fq);
        if (!has_next) break;
#pragma unroll
        for (int a = 0; a < 2; ++a)
#pragma unroll
            for (int b = 0; b < 2; ++b)
#pragma unroll
                for (int m = 0; m < 4; ++m)
#pragma unroll
                    for (int n = 0; n < 2; ++n) acc[a][b][m][n] = (f32x4){0.f, 0.f, 0.f, 0.f};
        cur = nxt; cB = nB; cA0[0] = nA0[0]; cA0[1] = nA0[1]; cA1[0] = nA1[0]; cA1[1] = nA1[1]; ++ui;
        if (wr == 1) PG8_BAR;
    }
    PG8_WAIT_V(0);
    PG8_BAR;
#undef PG8_SA
#undef PG8_SB
#undef PG8_STAGE_A
#undef PG8_STAGE_B
#undef PG8_LDA
#undef PG8_LDB
#undef PG8_MMA
#undef PG8_WAIT_V
#undef PG8_WAIT_L
#undef PG8_BAR
#undef PG8_SCHED
}

struct DenseSched {
    int nM, nN, nwg, G, c; const char* Bt; int K; bool skip_ctx;
    __device__ __forceinline__ void init(int M_, int N_, int K_, int G_, int c_, const void* Bt_, bool skip, int esz = 2) { nM = M_ / BM; nN = N_ / BM; nwg = nM * nN; G = G_; c = c_; Bt = (const char*)Bt_; K = esz * K_  ; skip_ctx = skip; if (skip) { nM = nM / 17 * 16; nwg = nM * nN; } }
    __device__ __forceinline__ bool next(int i, Unit& u) const {
        const long Lx = (long)i * G + c; if (Lx >= nwg) return false;
        int wgid = (int)Lx; { const int q = nwg / 8, r = nwg % 8, xcd = wgid % 8, off = wgid / 8; wgid = (xcd < r ? xcd * (q + 1) : r * (q + 1) + (xcd - r) * q) + off; }
        const int nig = 8 * nN, gid = wgid / nig, fm = gid * 8, gsz = (nM - fm) < 8 ? (nM - fm) : 8;
        int pm = fm + ((wgid % nig) % gsz); u.pn = (wgid % nig) / gsz;
        if (skip_ctx) pm = pm + pm / 16 + 1;
        u.pm = pm; u.e = 0; u.rt = 0; return true;
    }
    __device__ __forceinline__ void a_offs(const Unit& u, const int (&RA)[2], const int (&CA)[2], int rowB, unsigned (&o0)[2], unsigned (&o1)[2]) const {
#pragma unroll
        for (int i = 0; i < 2; ++i) { o0[i] = (unsigned)((u.pm * BM + RA[i]) * rowB + CA[i] * 2); o1[i] = (unsigned)((u.pm * BM + HALF + RA[i]) * rowB + CA[i] * 2); }
    }
    __device__ __forceinline__ const char* b_ptr(const Unit& u) const { return Bt + (size_t)u.pn * BM * K; }
};
struct OneSched {
    int pm, pn; const char* Bt; int K  ;
    __device__ __forceinline__ bool next(int i, Unit& u) const { if (i > 0) return false; u.pm = pm; u.pn = pn; u.e = 0; u.rt = 0; return true; }
    __device__ __forceinline__ void a_offs(const Unit& u, const int (&RA)[2], const int (&CA)[2], int rowB, unsigned (&o0)[2], unsigned (&o1)[2]) const {
#pragma unroll
        for (int i = 0; i < 2; ++i) { o0[i] = (unsigned)((u.pm * BM + RA[i]) * rowB + CA[i] * 2); o1[i] = (unsigned)((u.pm * BM + HALF + RA[i]) * rowB + CA[i] * 2); }
    }
    __device__ __forceinline__ const char* b_ptr(const Unit& u) const { return Bt + (size_t)u.pn * BM * K; }
};
template <bool GATHER>
struct MoeSched {
    int G, c, nN, K  ; const char* Bt; size_t estride; const LAS int* tp; const LAS int* cnt; const int* tok;
    __device__ __forceinline__ bool next(int i, Unit& u) const {
        const int Lx = i * G + c; const int ntile = tp[16];
        if (Lx >= ntile * nN) return false;
        const int pm = Lx / nN; u.pn = Lx - pm * nN; u.pm = pm;
        int e = 0;
#pragma unroll
        for (int j = 1; j < 16; ++j) e += (pm >= tp[j]) ? 1 : 0;
        u.e = e; u.rt = pm - tp[e]; return true;
    }
    __device__ __forceinline__ void a_offs(const Unit& u, const int (&RA)[2], const int (&CA)[2], int rowB, unsigned (&o0)[2], unsigned (&o1)[2]) const {
        if (GATHER) {
            const int n = cnt[u.e];
#pragma unroll
            for (int i = 0; i < 2; ++i) {
                const int p0 = u.rt * BM + RA[i], p1 = p0 + HALF;
                const int t0 = p0 < n ? tok[(size_t)u.e * CAP + p0] : 0, t1 = p1 < n ? tok[(size_t)u.e * CAP + p1] : 0;
                o0[i] = (unsigned)((t0 >> 1) * rowB + CA[i] * 2); o1[i] = (unsigned)((t1 >> 1) * rowB + CA[i] * 2);
            }
        } else {
#pragma unroll
            for (int i = 0; i < 2; ++i) { o0[i] = (unsigned)((u.pm * BM + RA[i]) * rowB + CA[i] * 2); o1[i] = (unsigned)((u.pm * BM + HALF + RA[i]) * rowB + CA[i] * 2); }
        }
    }
    __device__ __forceinline__ const char* b_ptr(const Unit& u) const { return Bt + (size_t)u.e * estride + (size_t)u.pn * BM * K; }
};

constexpr float WSCALE = 32.0f, WINV = 1.0f / 32.0f;
#define EPI_ARGS const f32x4 (&acc)[2][2][4][2], const Unit& u, int wr, int wc, int fr, int fq
__device__ __forceinline__ u32x4 pack8(f32x4 a, f32x4 b) { u32x4 w; w.x = cvt_pk_bf16(a[0], a[1]); w.y = cvt_pk_bf16(a[2], a[3]); w.z = cvt_pk_bf16(b[0], b[1]); w.w = cvt_pk_bf16(b[2], b[3]); return w; }
__device__ __forceinline__ unsigned char* qk8_ptr(unsigned char* QK8, int pm, int lr, int pn, int wc, int fq, int bj) {
    if (pn < 2) return QK8 + (size_t)(pm * BM + lr) * 1024 + pn * BM + wc * 32 + 8 * fq + bj * HALF;
    asm volatile("" : "+v"(lr));
    const int b = pm / 17, tb = pm - b * 17, h = (pn - 2) * 2 + bj;
    return QK8 + K8T_OFF + ((size_t)((b * 4 + h) * (LT / 64) + tb * 4 + (lr >> 6)) * 64 + (lr & 63)) * 128 + wc * 32 + 8 * fq;
}
struct EpiG1 {
    bf16_t* P; const float* ropec; const float* ropes; unsigned char* QK8;
    __device__ __forceinline__ void operator()(EPI_ARGS) const {
        const int pn = u.pn, tb = u.pm % 17;
        const bool rope = (tb != 0) && (pn < 4 || pn == 7 || pn == 8);
        const bool qk8 = pn < 4;
        const float sc = WINV * ((pn == 8) ? 0.125f : (pn < 2 ? 0.125f * 1.4426950408889634f * 4.0f : (pn < 4 ? 0.25f : 1.0f)));
        const int axis = wc & 1;
        if (rope) {
#pragma unroll
            for (int ai = 0; ai < 2; ++ai)
#pragma unroll
                for (int m = 0; m < 4; ++m) {
                    const int lr = ai * HALF + wr * 64 + m * 16 + fr;
                    const int gr = (tb - 1) * 4 + (lr >> 6), gc = lr & 63; const int pos = axis ? gc : gr;
                    f32x4 cs0 = *(const f32x4*)(ropec + pos * 16 + 4 * fq), sn0 = *(const f32x4*)(ropes + pos * 16 + 4 * fq);
                    cs0 = cs0 * sc; sn0 = sn0 * sc;
                    bf16_t* rowp = P + (size_t)(u.pm * BM + lr) * INW + pn * BM + wc * 32 + 8 * fq;
#pragma unroll
                    for (int bj = 0; bj < 2; ++bj) {
                        const f32x4 v0 = acc[ai][bj][m][0], v1 = acc[ai][bj][m][1];
                        f32x4 r0, r1;
                        r0[0] = v0[0] * cs0[0] - v0[1] * sn0[0]; r0[1] = v0[1] * cs0[0] + v0[0] * sn0[0];
                        r0[2] = v0[2] * cs0[1] - v0[3] * sn0[1]; r0[3] = v0[3] * cs0[1] + v0[2] * sn0[1];
                        r1[0] = v1[0] * cs0[2] - v1[1] * sn0[2]; r1[1] = v1[1] * cs0[2] + v1[0] * sn0[2];
                        r1[2] = v1[2] * cs0[3] - v1[3] * sn0[3]; r1[3] = v1[3] * cs0[3] + v1[2] * sn0[3];
                        if (qk8) { u32x2 w8; w8.x = pk4_fp8(r0[0], r0[1], r0[2], r0[3]); w8.y = pk4_fp8(r1[0], r1[1], r1[2], r1[3]); *(u32x2*)qk8_ptr(QK8, u.pm, lr, pn, wc, fq, bj) = w8; }
                        else *(u32x4*)(rowp + bj * HALF) = pack8(r0, r1);
                    }
                    if (m & 1) asm volatile("" ::: "memory");
                }
        } else {
#pragma unroll
            for (int ai = 0; ai < 2; ++ai)
#pragma unroll
                for (int m = 0; m < 4; ++m) {
                    const int lr = ai * HALF + wr * 64 + m * 16 + fr;
                    bf16_t* rowp = P + (size_t)(u.pm * BM + lr) * INW + pn * BM + wc * 32 + 8 * fq;
#pragma unroll
                    for (int bj = 0; bj < 2; ++bj) { const f32x4 a0 = acc[ai][bj][m][0] * sc, a1 = acc[ai][bj][m][1] * sc;
                        if (qk8) { u32x2 w8; w8.x = pk4_fp8(a0[0], a0[1], a0[2], a0[3]); w8.y = pk4_fp8(a1[0], a1[1], a1[2], a1[3]); *(u32x2*)qk8_ptr(QK8, u.pm, lr, pn, wc, fq, bj) = w8; }
                        else *(u32x4*)(rowp + bj * HALF) = pack8(a0, a1); }
                }
        }
    }
};
struct EpiG2 {
    const float* xin_lat; const float* xin_ctx; bf16_t* XB; const float* modl; bool first;
    __device__ __forceinline__ void operator()(EPI_ARGS) const {
        const int b = u.pm / 17, tb = u.pm - b * 17;
        const bool isctx = (tb == 0);
        const float* g = modl + (size_t)(isctx ? 8 : b) * 6144 + 2048;
        const int col0 = u.pn * BM + wc * 32 + 8 * fq;
        f32x4 gv[2][2];
#pragma unroll
        for (int bj = 0; bj < 2; ++bj) { gv[bj][0] = *(const f32x4*)(g + col0 + bj * HALF); gv[bj][1] = *(const f32x4*)(g + col0 + bj * HALF + 4); }
        if (first) {
            const size_t rbase = isctx ? (size_t)b * LC : (size_t)b * L + (size_t)(tb - 1) * BM;
            const float* src = isctx ? xin_ctx : xin_lat;
#pragma unroll
            for (int ai = 0; ai < 2; ++ai) {
                f32x4 o[4][2][2];
#pragma unroll
                for (int m = 0; m < 4; ++m) { const size_t off = (rbase + ai * HALF + wr * 64 + m * 16 + fr) * D + col0;
#pragma unroll
                    for (int bj = 0; bj < 2; ++bj) { o[m][bj][0] = *(const f32x4*)(src + off + bj * HALF); o[m][bj][1] = *(const f32x4*)(src + off + bj * HALF + 4); } }
                asm volatile("" ::: "memory");
#pragma unroll
                for (int m = 0; m < 4; ++m) { bf16_t* dp = XB + (size_t)(u.pm * BM + ai * HALF + wr * 64 + m * 16 + fr) * D + col0;
#pragma unroll
                    for (int bj = 0; bj < 2; ++bj) *(u32x4*)(dp + bj * HALF) = pack8(o[m][bj][0] + gv[bj][0] * acc[ai][bj][m][0], o[m][bj][1] + gv[bj][1] * acc[ai][bj][m][1]); }
                asm volatile("" ::: "memory");
            }
        } else {
#pragma unroll
            for (int ai = 0; ai < 2; ++ai) {
                u32x4 o[4][2];
#pragma unroll
                for (int m = 0; m < 4; ++m) { const bf16_t* sp = XB + (size_t)(u.pm * BM + ai * HALF + wr * 64 + m * 16 + fr) * D + col0;
#pragma unroll
                    for (int bj = 0; bj < 2; ++bj) o[m][bj] = *(const u32x4*)(sp + bj * HALF); }
                asm volatile("" ::: "memory");
#pragma unroll
                for (int m = 0; m < 4; ++m) { bf16_t* dp = XB + (size_t)(u.pm * BM + ai * HALF + wr * 64 + m * 16 + fr) * D + col0;
#pragma unroll
                    for (int bj = 0; bj < 2; ++bj) { const u32x4 w = o[m][bj];
                        const f32x4 x0 = bf4_to_f4((u32x2){w.x, w.y}), x1 = bf4_to_f4((u32x2){w.z, w.w});
                        *(u32x4*)(dp + bj * HALF) = pack8(x0 + gv[bj][0] * acc[ai][bj][m][0], x1 + gv[bj][1] * acc[ai][bj][m][1]); } }
                asm volatile("" ::: "memory");
            }
        }
    }
};
constexpr float YSCALE = 16.0f, YINV = 1.0f / 16.0f;
struct EpiE1 {
    unsigned char* ACT;
    __device__ __forceinline__ void operator()(EPI_ARGS) const {
        const int col0 = 8 * ((u.pn * 4 + wc) * 4 + fq);
#pragma unroll
        for (int ai = 0; ai < 2; ++ai)
#pragma unroll
            for (int m = 0; m < 4; ++m) {
                const int lr = ai * HALF + wr * 64 + m * 16 + fr;
                u32x2 w;
                { const f32x4 g = acc[ai][0][m][0] * WINV, up = acc[ai][0][m][1] * WINV; w.x = pk4_fp8(silu_f(g[0]) * up[0], silu_f(g[1]) * up[1], silu_f(g[2]) * up[2], silu_f(g[3]) * up[3]); }
                { const f32x4 g = acc[ai][1][m][0] * WINV, up = acc[ai][1][m][1] * WINV; w.y = pk4_fp8(silu_f(g[0]) * up[0], silu_f(g[1]) * up[1], silu_f(g[2]) * up[2], silu_f(g[3]) * up[3]); }
                *(u32x2*)(ACT + (size_t)(u.pm * BM + lr) * DE + col0) = w;
            }
    }
};
struct EpiE2 {
    unsigned char* Y2; const int* tok; const float* gate; const LAS int* cnt;
    __device__ __forceinline__ void operator()(EPI_ARGS) const {
        const int n = cnt[u.e];
        const int col0 = u.pn * BM + wc * 32 + 8 * fq;
        int pr[8]; float gt[8];
#pragma unroll
        for (int q = 0; q < 8; ++q) { const int pos = u.rt * BM + (q >> 2) * HALF + wr * 64 + (q & 3) * 16 + fr; pr[q] = pos < n ? tok[(size_t)u.e * CAP + pos] : -1; }
#pragma unroll
        for (int q = 0; q < 8; ++q) gt[q] = pr[q] >= 0 ? gate[pr[q]] * (WINV * YSCALE) : 0.f;
#pragma unroll
        for (int q = 0; q < 8; ++q) {
            if (pr[q] >= 0) {
                unsigned char* rowp = Y2 + (size_t)pr[q] * D + col0;
#pragma unroll
                for (int bj = 0; bj < 2; ++bj) { const f32x4 a0 = acc[q >> 2][bj][q & 3][0] * gt[q], a1 = acc[q >> 2][bj][q & 3][1] * gt[q];
                    u32x2 w; w.x = pk4_fp8(a0[0], a0[1], a0[2], a0[3]); w.y = pk4_fp8(a1[0], a1[1], a1[2], a1[3]); *(u32x2*)(rowp + bj * HALF) = w; }
            }
        }
    }
};
}

namespace att {
constexpr int NW = 8, QBLK = 32, KVBLK = 64;
constexpr float SCALE = 0.125f;
constexpr float THR = 8.f;
constexpr int NBUF = 3;
constexpr size_t SHM_V = KVBLK * 128 * 2, SHM_K = KVBLK * 128 * 2, SHM_ATTN = NBUF * SHM_V + NBUF * SHM_K + NW * 64 * 4;
#define KSWZ(row, colB) ((row) * 256 + ((colB) ^ (((row) & 7) << 4)))
#define SBAR() __builtin_amdgcn_sched_barrier(0)
__device__ __forceinline__ int crow(int r, int hi) { return (r & 3) + 8 * (r >> 2) + 4 * hi; }
__device__ __forceinline__ unsigned cvtpk(float lo, float hi) { unsigned r; asm volatile("v_cvt_pk_bf16_f32 %0, %1, %2" : "=v"(r) : "v"(lo), "v"(hi)); return r; }
__device__ __forceinline__ bf16x8 ld8(const bf16_t* p) { return *reinterpret_cast<const bf16x8*>(p); }

constexpr float C2 = SCALE * 1.4426950408889634f;
constexpr float THR2 = THR * 1.4426950408889634f;
__device__ __forceinline__ void partialSM(f32x16& p0, f32x16& p1, float& mhat, f32x16& negm, float& alpha) {
  float pmax = p0[0];
#pragma unroll
  for (int r = 1; r < 16; ++r) pmax = fmaxf(pmax, p0[r]);
#pragma unroll
  for (int r = 0; r < 16; ++r) pmax = fmaxf(pmax, p1[r]);
  { auto rr = __builtin_amdgcn_permlane32_swap(__float_as_uint(pmax), __float_as_uint(pmax), false, false);
    pmax = fmaxf(__uint_as_float(rr[0]), __uint_as_float(rr[1])); }
  if (__builtin_expect(__all(pmax <= THR2), 1)) { alpha = 1.f; }
  else { const float dl = fmaxf(pmax, 0.f); mhat += dl;
#pragma unroll
    for (int r = 0; r < 16; ++r) { p0[r] -= dl; p1[r] -= dl; }
#pragma unroll
    for (int r = 0; r < 16; ++r) negm[r] = -mhat;
    alpha = __builtin_amdgcn_exp2f(-dl); }
#pragma unroll
  for (int r = 0; r < 16; ++r) p0[r] = __builtin_amdgcn_exp2f(p0[r]);
}
#define PK4(P, BASE, OUT) do { unsigned a0 = cvtpk(P[BASE + 0], P[BASE + 1]), a1 = cvtpk(P[BASE + 2], P[BASE + 3]);   \
    unsigned b0 = cvtpk(P[BASE + 4], P[BASE + 5]), b1 = cvtpk(P[BASE + 6], P[BASE + 7]);                              \
    auto r0 = __builtin_amdgcn_permlane32_swap(a0, b0, false, false); auto r1 = __builtin_amdgcn_permlane32_swap(a1, b1, false, false); \
    u32x4 w = {r0[0], r1[0], r0[1], r1[1]}; OUT = *reinterpret_cast<bf16x8*>(&w); } while (0)
__device__ __forceinline__ void finishSM(f32x16& p0, f32x16& p1, float alpha, float& l_reg, bf16x8& pa0, bf16x8& pa1, bf16x8& pa2, bf16x8& pa3) {
#pragma unroll
  for (int r = 0; r < 16; ++r) p1[r] = __builtin_amdgcn_exp2f(p1[r]);
  float ps = 0;
#pragma unroll
  for (int r = 0; r < 16; ++r) ps += p0[r];
#pragma unroll
  for (int r = 0; r < 16; ++r) ps += p1[r];
  { auto rr = __builtin_amdgcn_permlane32_swap(__float_as_uint(ps), __float_as_uint(ps), false, false);
    ps = __uint_as_float(rr[0]) + __uint_as_float(rr[1]); }
  l_reg = l_reg * alpha + ps;
  PK4(p0, 0, pa0); PK4(p0, 8, pa1); PK4(p1, 0, pa2); PK4(p1, 8, pa3);
}
__device__ __forceinline__ void qkt(f32x16& p0, f32x16& p1, const bf16_t* Ks, const bf16x8* qr, int r32, int hi, int dbase, const f32x16& negm) {
#pragma unroll
  for (int d0 = 0; d0 < 4; ++d0) { int cb = (dbase + d0 * 16 + hi * 8) * 2;
    bf16x8 b0 = *reinterpret_cast<const bf16x8*>((const char*)Ks + KSWZ(r32, cb));
    bf16x8 b1 = *reinterpret_cast<const bf16x8*>((const char*)Ks + KSWZ(32 + r32, cb));
    if (d0 == 0) { p0 = __builtin_amdgcn_mfma_f32_32x32x16_bf16(b0, qr[0], negm, 0, 0, 0); p1 = __builtin_amdgcn_mfma_f32_32x32x16_bf16(b1, qr[0], negm, 0, 0, 0); }
    else { p0 = __builtin_amdgcn_mfma_f32_32x32x16_bf16(b0, qr[d0], p0, 0, 0, 0); p1 = __builtin_amdgcn_mfma_f32_32x32x16_bf16(b1, qr[d0], p1, 0, 0, 0); } }
}
template <int CPT> __device__ __forceinline__ int v_st(int k, int c) { const int kk = (k & ~0xC) | ((k & 4) << 1) | ((k & 8) >> 1); return ((kk >> 3) * CPT + (c >> 5)) * 512 + ((kk & 7) * 32 + (c & 31)) * 2; }
__device__ __forceinline__ int v_rd_base(int lane) { return ((lane & 3) << 3) | (((lane >> 2) & 3) << 6) | (((lane >> 4) & 1) << 5) | (((lane >> 5) & 1) << 8); }
template <int CPT> constexpr int v_rd_off(int d0, int ks, int half) { return d0 * 512 + ks * (CPT * 1024) + half * (CPT * 512); }
template <int OFF> __device__ __forceinline__ s16x4 tr_read(int vb) {
  s16x4 r; asm volatile("ds_read_b64_tr_b16 %0, %1 offset:%2" : "=&v"(r) : "v"(vb), "i"(OFF) : "memory"); return r;
}
template <int CPT, int D0> __device__ __forceinline__ void pv_one(f32x16& od, int vb, bf16x8 pa0, bf16x8 pa1, bf16x8 pa2, bf16x8 pa3) {
  const s16x4 l0 = tr_read<v_rd_off<CPT>(D0, 0, 0)>(vb), h0 = tr_read<v_rd_off<CPT>(D0, 0, 1)>(vb), l1 = tr_read<v_rd_off<CPT>(D0, 1, 0)>(vb), h1 = tr_read<v_rd_off<CPT>(D0, 1, 1)>(vb);
  const s16x4 l2 = tr_read<v_rd_off<CPT>(D0, 2, 0)>(vb), h2 = tr_read<v_rd_off<CPT>(D0, 2, 1)>(vb), l3 = tr_read<v_rd_off<CPT>(D0, 3, 0)>(vb), h3 = tr_read<v_rd_off<CPT>(D0, 3, 1)>(vb);
  asm volatile("s_waitcnt lgkmcnt(0)" ::: "memory"); SBAR();
#define PK(L_, H_) (bf16x8){L_[0], L_[1], L_[2], L_[3], H_[0], H_[1], H_[2], H_[3]}
  od = __builtin_amdgcn_mfma_f32_32x32x16_bf16(pa0, PK(l0, h0), od, 0, 0, 0);
  od = __builtin_amdgcn_mfma_f32_32x32x16_bf16(pa1, PK(l1, h1), od, 0, 0, 0);
  od = __builtin_amdgcn_mfma_f32_32x32x16_bf16(pa2, PK(l2, h2), od, 0, 0, 0);
  od = __builtin_amdgcn_mfma_f32_32x32x16_bf16(pa3, PK(l3, h3), od, 0, 0, 0);
#undef PK
}
__device__ __forceinline__ void pv4(f32x16* o, int vb, bf16x8 pa0, bf16x8 pa1, bf16x8 pa2, bf16x8 pa3) {
  pv_one<4, 0>(o[0], vb, pa0, pa1, pa2, pa3); pv_one<4, 1>(o[1], vb, pa0, pa1, pa2, pa3); pv_one<4, 2>(o[2], vb, pa0, pa1, pa2, pa3); pv_one<4, 3>(o[3], vb, pa0, pa1, pa2, pa3);
}
__device__ __forceinline__ void pv2(f32x16* o, int vb, bf16x8 pa0, bf16x8 pa1, bf16x8 pa2, bf16x8 pa3) {
  pv_one<2, 0>(o[0], vb, pa0, pa1, pa2, pa3); pv_one<2, 1>(o[1], vb, pa0, pa1, pa2, pa3);
}

__device__ __forceinline__ void attn_unit(const bf16_t* __restrict__ P, int qrow0, int krow0, int seq, int h, float lam, const float* __restrict__ nw, float oscale, bf16_t* __restrict__ MIX, char* lds, const int wave0) {
  const int tid = opaque_tid(wave0), wid = tid >> 6, lane = tid & 63, r32 = lane & 31, hi = lane >> 5;
  const int map = wid >> 2, wq = wid & 3;
  bf16_t* V_lds = (bf16_t*)lds; bf16_t* K_lds = (bf16_t*)(lds + NBUF * SHM_V);
  float* ws = (float*)(lds + NBUF * SHM_V + NBUF * SHM_K) + wid * 64; float* li_l = ws; float* al_l = ws + 32;
  float m_reg = 0.f  , l_reg = 0; f32x16 o[4] = {}; bf16x8 qr[4]; f32x16 negm = {};
  const bf16_t* Qw = P + (size_t)(qrow0 + wq * QBLK + r32) * INW + OFF_DQ + h * 128 + map * 64 + hi * 8;
#pragma unroll
  for (int d0 = 0; d0 < 4; ++d0) { const bf16x8 raw = ld8(Qw + d0 * 16); u32x4 w;
#pragma unroll
    for (int z = 0; z < 4; ++z) w[z] = cvtpk(bf2f((bf16_t)raw[2 * z]) * C2, bf2f((bf16_t)raw[2 * z + 1]) * C2);
    qr[d0] = *reinterpret_cast<bf16x8*>(&w); }
  const bf16_t* Kh = P + (size_t)krow0 * INW + OFF_DK + h * 128;
  const bf16_t* Vh = P + (size_t)krow0 * INW + OFF_DV + h * 128;
  const int sr = tid >> 4, sc = (tid & 15) * 8, vst0 = v_st<4>(sr, sc), vst1 = v_st<4>(32 + sr, sc);
  const int vb0 = (int)(uintptr_t)V_lds + v_rd_base(lane);
  const int dbase = map * 64;
  struct { bf16x8 vs0, vs1, ks0, ks1; } sr_[2];
#define SLOAD(i, k0) do { sr_[i].vs0 = ld8(&Vh[(size_t)((k0) + sr) * INW + sc]); sr_[i].vs1 = ld8(&Vh[(size_t)((k0) + 32 + sr) * INW + sc]); \
    sr_[i].ks0 = ld8(&Kh[(size_t)((k0) + sr) * INW + sc]); sr_[i].ks1 = ld8(&Kh[(size_t)((k0) + 32 + sr) * INW + sc]); } while (0)
#define SWRITE(b, i) do { *(bf16x8*)((char*)V_lds + (b) * SHM_V + vst0) = sr_[i].vs0;          \
    *(bf16x8*)((char*)V_lds + (b) * SHM_V + vst1) = sr_[i].vs1; int kc = sc * 2;               \
    *(bf16x8*)((char*)K_lds + (b) * SHM_K + KSWZ(sr, kc)) = sr_[i].ks0;                       \
    *(bf16x8*)((char*)K_lds + (b) * SHM_K + KSWZ(32 + sr, kc)) = sr_[i].ks1; } while (0)
#define SWAIT() asm volatile("s_waitcnt vmcnt(4)" ::: "memory")
#define RESC(a) do { if (__any((a) < 1.f)) { if (hi == 0) al_l[r32] = (a); asm volatile("s_waitcnt lgkmcnt(0)" ::: "memory"); \
    _Pragma("unroll") for (int d = 0; d < 4; ++d) _Pragma("unroll") for (int r = 0; r < 16; ++r) o[d][r] *= al_l[crow(r, hi)]; } } while (0)
  f32x16 pA0, pA1, pB0, pB1; float alA, alB; bf16x8 pa0, pa1, pa2, pa3; const int NT = seq / KVBLK;
  constexpr int SE = 0, SO = 1;
  int bprev = 0, bcur = 1, bnext = 2;
#define KBUF(b) ((bf16_t*)((char*)K_lds + (b) * (int)SHM_K))
#define VBUF(b) (vb0 + (b) * (int)SHM_V)
#define ROT3() do { const int t_ = bprev; bprev = bcur; bcur = bnext; bnext = t_; } while (0)
  SLOAD(SE, 0); asm volatile("s_waitcnt vmcnt(0)" ::: "memory"); SWRITE(0, SE);
  SLOAD(SO, KVBLK); SLOAD(SE, 2 * KVBLK);
  __syncthreads();
  qkt(pA0, pA1, KBUF(0), qr, r32, hi, dbase, negm); partialSM(pA0, pA1, m_reg, negm, alA);
  SWAIT(); SWRITE(1, SO); __syncthreads();
  for (int j = 1; j + 1 < NT; j += 2) {
    SBAR(); qkt(pB0, pB1, KBUF(bcur), qr, r32, hi, dbase, negm);
    finishSM(pA0, pA1, alA, l_reg, pa0, pa1, pa2, pa3); SBAR();
    SLOAD(SO, (j + 2) * KVBLK); SBAR();
    pv4(o, VBUF(bprev), pa0, pa1, pa2, pa3); partialSM(pB0, pB1, m_reg, negm, alB);
    SWAIT(); SWRITE(bnext, SE);
    RESC(alB); __syncthreads(); ROT3();
    SBAR(); qkt(pA0, pA1, KBUF(bcur), qr, r32, hi, dbase, negm);
    finishSM(pB0, pB1, alB, l_reg, pa0, pa1, pa2, pa3); SBAR();
    if (j + 3 < NT) SLOAD(SE, (j + 3) * KVBLK); SBAR();
    pv4(o, VBUF(bprev), pa0, pa1, pa2, pa3); partialSM(pA0, pA1, m_reg, negm, alA);
    if (j + 3 < NT) SWAIT(); else asm volatile("s_waitcnt vmcnt(0)" ::: "memory");
    SWRITE(bnext, SO);
    RESC(alA); __syncthreads(); ROT3();
  }
  SBAR(); qkt(pB0, pB1, KBUF(bcur), qr, r32, hi, dbase, negm);
  finishSM(pA0, pA1, alA, l_reg, pa0, pa1, pa2, pa3); SBAR();
  pv4(o, VBUF(bprev), pa0, pa1, pa2, pa3); partialSM(pB0, pB1, m_reg, negm, alB);
  RESC(alB);
  finishSM(pB0, pB1, alB, l_reg, pa0, pa1, pa2, pa3); SBAR();
  pv4(o, VBUF(bcur), pa0, pa1, pa2, pa3);
#undef KBUF
#undef VBUF
#undef ROT3
  { const int tid_e = opaque_tid(wave0), lane_e = tid_e & 63; const int lane = lane_e, r32 = lane_e & 31, hi = lane_e >> 5, wid = tid_e >> 6, map = wid >> 2, wq = wid & 3; (void)map; (void)wq;
  if (hi == 0) li_l[r32] = l_reg; asm volatile("s_waitcnt lgkmcnt(0)" ::: "memory");
  float rli[16];
#pragma unroll
  for (int r = 0; r < 16; ++r) rli[r] = __builtin_amdgcn_rcpf(li_l[crow(r, hi)]);
  __syncthreads();
  float* stash = (float*)lds + wq * 4096;
  if (map == 1) {
#pragma unroll
    for (int d0 = 0; d0 < 4; ++d0)
#pragma unroll
      for (int r = 0; r < 16; ++r) stash[(d0 * 16 + r) * 64 + lane] = lam * o[d0][r] * rli[r];
  }
  __syncthreads();
  if (map == 0) {
    float rs[16];
#pragma unroll
    for (int r = 0; r < 16; ++r) {
      float ss = 0.f;
#pragma unroll
      for (int d0 = 0; d0 < 4; ++d0) { const float a = o[d0][r] * rli[r] - stash[(d0 * 16 + r) * 64 + lane]; o[d0][r] = a; ss += a * a; }
      ss = half_sum32(ss, lane);
      rs[r] = oscale / sqrtf(ss * (1.0f / 128.0f) + EPS);
    }
    float nwv[4];
#pragma unroll
    for (int d0 = 0; d0 < 4; ++d0) nwv[d0] = nw[d0 * 32 + r32];
    bf16_t* Ow = MIX + (size_t)(qrow0 + wq * QBLK) * D + h * 128;
#pragma unroll
    for (int r = 0; r < 16; ++r) { const int orow = crow(r, hi);
#pragma unroll
      for (int d0 = 0; d0 < 4; ++d0) Ow[(size_t)orow * D + d0 * 32 + r32] = f2bf(o[d0][r] * rs[r] * nwv[d0]); }
  }
  }
  __syncthreads();
#undef SLOAD
#undef SWRITE
#undef SWAIT
#undef RESC
}

typedef int v8i __attribute__((ext_vector_type(8)));
typedef int v4i __attribute__((ext_vector_type(4)));
constexpr int DIST8 = 4, NB8 = DIST8 + 2, K8B = 8192, V8B = 8192 + 2048;
__device__ __forceinline__ v8i ldsrd32(const char* p0, const char* p1) { const v4i a = *(const v4i*)p0, b = *(const v4i*)p1; return __builtin_shufflevector(a, b, 0, 1, 2, 3, 4, 5, 6, 7); }
#define MFMA8_NEW(D_, A_, B_, C_, SC_, SCB_) asm volatile("v_mfma_scale_f32_32x32x64_f8f6f4 %0, %1, %2, %3, %4, %5 op_sel_hi:[0,0,0]" : "=&v"(D_) : "v"(A_), "v"(B_), "v"(C_), "v"(SC_), "v"(SCB_))
#define MFMA8_ACC(D_, A_, B_, SC_) asm volatile("v_mfma_scale_f32_32x32x64_f8f6f4 %0, %1, %2, %0, %3, %3 op_sel_hi:[0,0,0]" : "+v"(D_) : "v"(A_), "v"(B_), "v"(SC_))
constexpr float P8_U = 1.0f / 65536.0f;
constexpr float P8_ONE = 96.0f * P8_U;
constexpr float THR8 = 28.0f * P8_U;
__device__ __forceinline__ void partialSM8(f32x16& p0, f32x16& p1, float& mhat, f32x16& negm, float& alpha) {
  float pmax = p0[0];
#pragma unroll
  for (int r = 1; r < 16; ++r) pmax = fmaxf(pmax, p0[r]);
#pragma unroll
  for (int r = 0; r < 16; ++r) pmax = fmaxf(pmax, p1[r]);
  { auto rr = __builtin_amdgcn_permlane32_swap(__float_as_uint(pmax), __float_as_uint(pmax), false, false);
    pmax = fmaxf(__uint_as_float(rr[0]), __uint_as_float(rr[1])); }
  if (__builtin_expect(__all(pmax <= P8_ONE + THR8), 1)) { alpha = 1.f; }
  else { const float dl = fmaxf(pmax - P8_ONE, 0.f); mhat += dl;
#pragma unroll
    for (int r = 0; r < 16; ++r) { p0[r] -= dl; p1[r] -= dl; }
#pragma unroll
    for (int r = 0; r < 16; ++r) negm[r] -= dl;
    alpha = __builtin_amdgcn_exp2f(-0.125f * 65536.0f * dl); }
}
__device__ __forceinline__ float max16(const f32x16& p, float m) {
  asm("v_max3_f32 %0, %0, %1, %2\n\tv_max3_f32 %0, %0, %3, %4\n\tv_max3_f32 %0, %0, %5, %6\n\tv_max3_f32 %0, %0, %7, %8\n\tv_max3_f32 %0, %0, %9, %10\n\tv_max3_f32 %0, %0, %11, %12\n\tv_max3_f32 %0, %0, %13, %14\n\tv_max3_f32 %0, %0, %15, %16"
      : "+v"(m) : "v"(p[0]), "v"(p[1]), "v"(p[2]), "v"(p[3]), "v"(p[4]), "v"(p[5]), "v"(p[6]), "v"(p[7]), "v"(p[8]), "v"(p[9]), "v"(p[10]), "v"(p[11]), "v"(p[12]), "v"(p[13]), "v"(p[14]), "v"(p[15]));
  return m;
}
__device__ __forceinline__ void decideSM8(float pmax, f32x16& p0, f32x16& p1, f32x16& negm, float& alpha) {
  if (__builtin_expect(__all(pmax <= P8_ONE + THR8), 1)) { alpha = 1.f; }
  else {
    { auto rr = __builtin_amdgcn_permlane32_swap(__float_as_uint(pmax), __float_as_uint(pmax), false, false);
      const float a_ = __uint_as_float(rr[0]), b_ = __uint_as_float(rr[1]); asm("v_max_f32 %0, %1, %2" : "=v"(pmax) : "v"(a_), "v"(b_)); }
    const float dl = fmaxf(pmax - P8_ONE, 0.f);
#pragma unroll
    for (int r = 0; r < 16; ++r) { p0[r] -= dl; p1[r] -= dl; }
#pragma unroll
    for (int r = 0; r < 16; ++r) negm[r] -= dl;
    alpha = __builtin_amdgcn_exp2f(-0.125f * 65536.0f * dl); }
}
typedef unsigned short us2_t __attribute__((ext_vector_type(2)));
__device__ __forceinline__ unsigned pk4_u8(float a, float b, float c, float d) {
  const us2_t w0 = __builtin_amdgcn_cvt_pknorm_u16(a, b), w1 = __builtin_amdgcn_cvt_pknorm_u16(c, d);
  return __builtin_amdgcn_perm(__builtin_bit_cast(unsigned, w1), __builtin_bit_cast(unsigned, w0), 0x06040200u); }
__device__ __forceinline__ void finishSM8(f32x16& p0, f32x16& p1, v8i& pa) {
#pragma unroll
  for (int g = 0; g < 4; ++g) { pa[g] = (int)pk4_u8(p0[4 * g], p0[4 * g + 1], p0[4 * g + 2], p0[4 * g + 3]); pa[4 + g] = (int)pk4_u8(p1[4 * g], p1[4 * g + 1], p1[4 * g + 2], p1[4 * g + 3]); }
}
__device__ __forceinline__ void qkt8(f32x16& p0, f32x16& p1, const char* Kb, const v8i& q8, int r32, int hi, int map, const f32x16& negm, int sc1, int sc8) {
  const int c0 = 4 * map + 2 * hi;
  const int sw0 = (r32 >> 1) & 7;
  const char* ra = Kb + r32 * 128; const char* rb = Kb + (32 + r32) * 128;
  const v8i k0 = ldsrd32(ra + ((c0 ^ sw0) << 4), ra + (((c0 + 1) ^ sw0) << 4));
  const v8i k1 = ldsrd32(rb + ((c0 ^ sw0) << 4), rb + (((c0 + 1) ^ sw0) << 4));
  MFMA8_NEW(p0, k0, q8, negm, sc1, sc8);
  MFMA8_NEW(p1, k1, q8, negm, sc1, sc8);
  asm volatile("s_nop 15\n\ts_nop 15" : "+v"(p0), "+v"(p1));
}
__device__ __forceinline__ void pv8(f32x16* o, const char* Vb, const v8i& pa, int r32, int hi, int sc1) {
  asm volatile("s_nop 4" ::: "memory");
#pragma unroll
  for (int eb = 0; eb < 5; ++eb) { const int e = 32 * eb + r32; const int sw = (e >> 2) & 3; const char* rp = Vb + e * 64;
    const v8i vf = ldsrd32(rp + (((2 * hi) ^ sw) << 4), rp + (((2 * hi + 1) ^ sw) << 4));
    MFMA8_ACC(o[eb], vf, pa, sc1); }
}
__device__ __forceinline__ void attn_unit8(const unsigned char* __restrict__ QK8, const unsigned char* __restrict__ VT8, int qrow0, int krow0, int seq, int bh, int h, float lam, const float* __restrict__ nw, float oscale, bf16_t* __restrict__ MIX, char* lds, const int wave0) {
  const int tid = opaque_tid(wave0), wid = tid >> 6, lane = tid & 63, r32 = lane & 31, hi = lane >> 5;
  const int map = wid >> 2, wq = wid & 3;
  char* V_lds = lds; char* K_lds = lds + NB8 * V8B;
  float* ws = (float*)(lds + NB8 * V8B + NB8 * K8B) + wid * 64; float* al_l = ws + 32;
  int sc1 = 0x7F7F7F7F; asm volatile("" : "+v"(sc1));
  int sc8 = 0x72727272; asm volatile("" : "+v"(sc8));
  float m_reg = 0.f; f32x16 o[5] = {}; f32x16 negm;
#pragma unroll
  for (int r = 0; r < 16; ++r) negm[r] = P8_ONE;
  v8i q8;
  { const unsigned char* qp = QK8 + (size_t)(qrow0 + wq * QBLK + r32) * 1024 + h * 128 + map * 64 + hi * 32;
    const v4i a = *(const v4i*)qp, b = *(const v4i*)(qp + 16); q8 = __builtin_shufflevector(a, b, 0, 1, 2, 3, 4, 5, 6, 7); }
  const unsigned char* Kg = QK8 + K8T_OFF + (size_t)bh * (LT / 64) * 8192;
  const unsigned char* Vg = VT8 + (size_t)bh * (LT / 64) * 8192;
  const unsigned kgo = (unsigned)((tid >> 3) * 128 + (((tid & 7) ^ ((tid >> 4) & 7)) << 4)), vgo = (unsigned)((tid >> 2) * 64 + (((tid & 3) ^ ((tid >> 4) & 3)) << 4));
  const int wdst = __builtin_amdgcn_readfirstlane(wid) * 1024;
#define SDMA8(t, bb) do { const int b_ = (bb); \
    const unsigned char* kt_ = Kg + (size_t)(unsigned)(t) * 8192; const unsigned char* vt_ = Vg + (size_t)(unsigned)(t) * 8192; asm volatile("" : "+s"(kt_), "+s"(vt_));     \
    __builtin_amdgcn_global_load_lds((const unsigned*)(kt_ + kgo), (LAS unsigned*)(LAS char*)(K_lds + b_ * K8B + wdst), 16, 0, 0); \
    __builtin_amdgcn_global_load_lds((const unsigned*)(vt_ + vgo), (LAS unsigned*)(LAS char*)(V_lds + b_ * V8B + wdst), 16, 0, 0); } while (0)
#define TBAR8(n) do { asm volatile("s_waitcnt vmcnt(%0)\n\ts_waitcnt lgkmcnt(0)" :: "n"(n) : "memory"); __builtin_amdgcn_s_barrier(); asm volatile("" ::: "memory"); } while (0)
#define RESC8(a) do { if (__any((a) < 1.f)) { asm volatile("s_nop 15\n\ts_nop 15" : "+v"(o[0]), "+v"(o[1]), "+v"(o[2]), "+v"(o[3]), "+v"(o[4]));     \
    _Pragma("unroll") for (int d = 0; d < 5; ++d) _Pragma("unroll") for (int r = 0; r < 16; ++r) o[d][r] *= (a); } } while (0)
  f32x16 pA0, pA1, pB0, pB1; float alA, alB; v8i pa; const int NT = seq / KVBLK;
#define KBUF8(b) (K_lds + (b) * K8B)
#define VBUF8(b) (V_lds + (b) * V8B)
  const int o8_ = opaque_int(0x38383838);
  for (int i = tid; i < NB8 * 128; i += 512) *(v4i*)(V_lds + (i >> 7) * V8B + 8192 + (i & 127) * 16) = (v4i){o8_, o8_, o8_, o8_};
#pragma unroll
  for (int t = 0; t <= DIST8; ++t) SDMA8(t < NT ? t : NT - 1, t);
  TBAR8(2 * DIST8);
  qkt8(pA0, pA1, KBUF8(0), q8, r32, hi, map, negm, sc1, sc8); partialSM8(pA0, pA1, m_reg, negm, alA);
  TBAR8(2 * (DIST8 - 2));
  const int kof0 = r32 * 128 + (((4 * map + 2 * hi) ^ ((r32 >> 1) & 7)) << 4), kof1 = r32 * 128 + (((4 * map + 2 * hi + 1) ^ ((r32 >> 1) & 7)) << 4);
  const int vof0 = r32 * 64 + (((2 * hi) ^ ((r32 >> 2) & 3)) << 4), vof1 = r32 * 64 + (((2 * hi + 1) ^ ((r32 >> 2) & 3)) << 4);
#define VF8(Vb_, f_) ldsrd32((Vb_) + vof0 + (f_) * 2048, (Vb_) + vof1 + (f_) * 2048)
  unsigned kl0 = (unsigned)(uintptr_t)(LAS char*)K_lds + (unsigned)kof0, kl1 = (unsigned)(uintptr_t)(LAS char*)K_lds + (unsigned)kof1; asm volatile("" : "+v"(kl0), "+v"(kl1));
#define KF8I(b_, f_) __builtin_shufflevector(*(const LAS v4i*)(uintptr_t)(kl0 + (unsigned)((b_) * K8B + (f_) * 4096)), *(const LAS v4i*)(uintptr_t)(kl1 + (unsigned)((b_) * K8B + (f_) * 4096)), 0, 1, 2, 3, 4, 5, 6, 7)
  v8i kf0 = KF8I(1, 0), kf1 = KF8I(1, 1);
#define HSTEP8(jt, pX0, pX1, alX, pY0, pY1, B1_, BN_, B2_) do { \
    const char* Vb_ = VBUF8(B1_); float mx_; \
    SBAR(); \
    MFMA8_NEW(pX0, kf0, q8, negm, sc1, sc8); \
    SBAR(); \
    v8i va_ = VF8(Vb_, 0), vb_ = VF8(Vb_, 1); const v8i vc_ = VF8(Vb_, 2); \
    _Pragma("unroll") for (int g = 0; g < 4; ++g) pa[g] = (int)pk4_u8(pY0[4 * g], pY0[4 * g + 1], pY0[4 * g + 2], pY0[4 * g + 3]); \
    SBAR(); \
    MFMA8_NEW(pX1, kf1, q8, negm, sc1, sc8); \
    SBAR(); \
    _Pragma("unroll") for (int g = 0; g < 4; ++g) pa[4 + g] = (int)pk4_u8(pY1[4 * g], pY1[4 * g + 1], pY1[4 * g + 2], pY1[4 * g + 3]); \
    { const int tn_ = (jt) + DIST8 < NT ? (jt) + DIST8 : NT - 1; SDMA8(tn_, B2_); }     \
    SBAR(); \
    asm volatile("s_nop 4" ::: "memory"); \
    MFMA8_ACC(o[0], va_, pa, sc1); va_ = VF8(Vb_, 3); SBAR(); \
    MFMA8_ACC(o[1], vb_, pa, sc1); vb_ = VF8(Vb_, 4); kf0 = KF8I(BN_, 0); kf1 = KF8I(BN_, 1); mx_ = max16(pX0, pX0[0]); SBAR(); \
    MFMA8_ACC(o[2], vc_, pa, sc1); mx_ = max16(pX1, mx_); SBAR(); \
    MFMA8_ACC(o[3], va_, pa, sc1); \
    MFMA8_ACC(o[4], vb_, pa, sc1); \
    if (__builtin_expect(!__all(mx_ <= P8_ONE + THR8), 0)) { decideSM8(mx_, pX0, pX1, negm, alX); RESC8(alX); }     \
    TBAR8(2 * (DIST8 - 2)); } while (0)
  int j = 1;
  for (; j + 6 <= NT - 1; j += 6) {
    HSTEP8(j,     pB0, pB1, alB, pA0, pA1, 0, 2, 5);
    HSTEP8(j + 1, pA0, pA1, alA, pB0, pB1, 1, 3, 0);
    HSTEP8(j + 2, pB0, pB1, alB, pA0, pA1, 2, 4, 1);
    HSTEP8(j + 3, pA0, pA1, alA, pB0, pB1, 3, 5, 2);
    HSTEP8(j + 4, pB0, pB1, alB, pA0, pA1, 4, 0, 3);
    HSTEP8(j + 5, pA0, pA1, alA, pB0, pB1, 5, 1, 4);
  }
  static_assert(NB8 == 6, "the unrolled trip walks a ring of six");
  for (; j + 1 < NT; j += 2) {
    const int c1 = (j - 1) % NB8, c0 = j % NB8, cn = (j + 1) % NB8, cnn = (j + 2) % NB8, c2 = (j + NB8 - 2) % NB8;
    HSTEP8(j,     pB0, pB1, alB, pA0, pA1, c1, cn, c2);
    HSTEP8(j + 1, pA0, pA1, alA, pB0, pB1, c0, cnn, c1);
  }
  const int b1 = (NT - 2) % NB8, b0 = (NT - 1) % NB8;
  SBAR(); MFMA8_NEW(pB0, kf0, q8, negm, sc1, sc8); MFMA8_NEW(pB1, kf1, q8, negm, sc1, sc8); SBAR();
  finishSM8(pA0, pA1, pa); SBAR();
  pv8(o, VBUF8(b1), pa, r32, hi, sc1); partialSM8(pB0, pB1, m_reg, negm, alB);
  RESC8(alB);
  finishSM8(pB0, pB1, pa); SBAR();
  pv8(o, VBUF8(b0), pa, r32, hi, sc1);
  asm volatile("s_nop 15\n\ts_nop 15" : "+v"(o[0]), "+v"(o[1]), "+v"(o[2]), "+v"(o[3]), "+v"(o[4]));
#undef HSTEP8
#undef VF8
#undef KF8I
#undef KBUF8
#undef VBUF8
#undef SDMA8
#undef TBAR8
  { const int tid_e = opaque_tid(wave0), lane_e = tid_e & 63; const int lane = lane_e, r32 = lane_e & 31, hi = lane_e >> 5, wid = tid_e >> 6, map = wid >> 2, wq = wid & 3; (void)map; (void)wq;
  const float rl = __builtin_amdgcn_rcpf(o[4][0]);
  asm volatile("s_waitcnt vmcnt(0)" ::: "memory");
  __syncthreads();
  float* stash = (float*)lds + wq * 4096;
  if (map == 1) { const float f_ = lam * rl;
#pragma unroll
    for (int d0 = 0; d0 < 4; ++d0)
#pragma unroll
      for (int r = 0; r < 16; ++r) stash[(d0 * 16 + r) * 64 + lane] = f_ * o[d0][r];
  }
  __syncthreads();
  if (map == 0) {
    float ss = 0.f;
#pragma unroll
    for (int d0 = 0; d0 < 4; ++d0)
#pragma unroll
      for (int r = 0; r < 16; ++r) { const float a = o[d0][r] * rl - stash[(d0 * 16 + r) * 64 + lane]; o[d0][r] = a; ss += a * a; }
    { auto rr = __builtin_amdgcn_permlane32_swap(__float_as_uint(ss), __float_as_uint(ss), false, false); ss = __uint_as_float(rr[0]) + __uint_as_float(rr[1]); }
    const float rs = oscale * __builtin_amdgcn_rsqf(ss * (1.0f / 128.0f) + EPS);
    bf16_t* Ow = MIX + (size_t)(qrow0 + wq * QBLK + r32) * D + h * 128 + 4 * hi;
#pragma unroll
    for (int d0 = 0; d0 < 4; ++d0)
#pragma unroll
      for (int g = 0; g < 4; ++g) { const f32x4 w4 = *(const f32x4*)(nw + 32 * d0 + 8 * g + 4 * hi);
        u32x2 ow; ow.x = cvt_pk_bf16(o[d0][4 * g] * rs * w4[0], o[d0][4 * g + 1] * rs * w4[1]); ow.y = cvt_pk_bf16(o[d0][4 * g + 2] * rs * w4[2], o[d0][4 * g + 3] * rs * w4[3]);
        *(u32x2*)(Ow + 32 * d0 + 8 * g) = ow; }
  }
  }
  __syncthreads();
#undef RESC8
}
}

struct Params {
    const float *x, *c, *ctx, *c_ctx, *w_in, *w_out, *ada_w, *ada_b, *norm1_w, *norm2_w, *diff_lambda, *diff_norm_w, *pool_w, *pool_scale,
                *ret_a_f, *ret_a_b, *ret_norm_w, *router_w, *router_b, *moe_g, *moe_u, *moe_d, *final_norm_w;
    float* out; unsigned char* ws;
};

__device__ __forceinline__ int rowmap(int kind, int n) {
    if (kind == 0) {
        const bool rope = (n < 1024) || (n >= OFF_RQ && n < OFF_RV);
        if (rope) { const int d = n & 63; return (n & ~63) + ((d >> 5) << 5) + ((d & 15) << 1) + ((d >> 4) & 1); }
        return n;
    } else if (kind == 1) return n;
    else {
        const int a = n >> 2, j = n & 3, bj = a & 1, t = a >> 1, fq = t & 3, wc = (t >> 2) & 3, pn = t >> 4;
        return pn * 256 + bj * 128 + wc * 32 + 8 * fq + j + (kind == 3 ? 4 : 0);
    }
}
__device__ __forceinline__ void transpose_item(const float* W, int K, int N, bf16_t* WT, int kind, float* scr, int item, int lane) {
    const int nblk = N / 32, kb = item / nblk, nb = item % nblk, k0 = 64 * kb, n0 = 32 * nb;
    float tv[32];
#pragma unroll
    for (int i = 0; i < 32; ++i) tv[i] = W[(size_t)(k0 + 2 * i + (lane >> 5)) * N + n0 + (lane & 31)];
#pragma unroll
    for (int i = 0; i < 32; ++i) scr[(2 * i + (lane >> 5)) * 33 + (lane & 31)] = tv[i];
    asm volatile("s_waitcnt lgkmcnt(0)" ::: "memory");
    const int c = lane & 7;
#pragma unroll
    for (int j = 0; j < 4; ++j) { const int n = (lane >> 3) + 8 * j; const float* s = scr + (8 * c) * 33 + n;
        u32x4 o; o.x = cvt_pk_bf16(s[0 * 33], s[1 * 33]); o.y = cvt_pk_bf16(s[2 * 33], s[3 * 33]); o.z = cvt_pk_bf16(s[4 * 33], s[5 * 33]); o.w = cvt_pk_bf16(s[6 * 33], s[7 * 33]);
        *(u32x4*)(WT + (size_t)rowmap(kind, n0 + n) * K + k0 + 8 * c) = o; }
    asm volatile("s_waitcnt lgkmcnt(0)" ::: "memory");
}

__device__ __forceinline__ const void* ldp(volatile LAS unsigned* tab, int k) {
    const unsigned lo = tab[2 * k], hi = tab[2 * k + 1];
    const unsigned long long v = ((unsigned long long)(unsigned)__builtin_amdgcn_readfirstlane(hi) << 32) | (unsigned long long)(unsigned)__builtin_amdgcn_readfirstlane(lo);
    const GAS char* g = (const GAS char*)v;
    return (const void*)g;
}
enum { I_X = 0, I_C, I_CTX, I_CCTX, I_WIN, I_WOUT, I_ADAW, I_ADAB, I_N1W, I_N2W, I_DLAM, I_DNW, I_POOLW, I_POOLS, I_RAF, I_RAB, I_RNW, I_RW, I_RB, I_MG, I_MU, I_MD, I_FNW, I_OUT, I_WS };
__device__ __forceinline__ void transpose_item_fp8(const float* W, int K, int N, unsigned char* WT, int kind, float* scr, int item, int lane) {
    const int nblk = N / 32, kb = item / nblk, nb = item % nblk, k0 = 64 * kb, n0 = 32 * nb;
    float tv[32];
#pragma unroll
    for (int i = 0; i < 32; ++i) tv[i] = W[(size_t)(k0 + 2 * i + (lane >> 5)) * N + n0 + (lane & 31)];
#pragma unroll
    for (int i = 0; i < 32; ++i) scr[(2 * i + (lane >> 5)) * 33 + (lane & 31)] = tv[i];
    asm volatile("s_waitcnt lgkmcnt(0)" ::: "memory");
    const int c = lane & 7;
#pragma unroll
    for (int j = 0; j < 4; ++j) { const int n = (lane >> 3) + 8 * j; const float* sp = scr + (8 * c) * 33 + n;
        u32x2 o; o.x = pk4_fp8(sp[0 * 33] * pg8::WSCALE, sp[1 * 33] * pg8::WSCALE, sp[2 * 33] * pg8::WSCALE, sp[3 * 33] * pg8::WSCALE);
        o.y = pk4_fp8(sp[4 * 33] * pg8::WSCALE, sp[5 * 33] * pg8::WSCALE, sp[6 * 33] * pg8::WSCALE, sp[7 * 33] * pg8::WSCALE);
        *(u32x2*)(WT + (size_t)rowmap(kind, n0 + n) * K + k0 + 8 * c) = o; }
    asm volatile("s_waitcnt lgkmcnt(0)" ::: "memory");
}
#ifndef PHMASK
#define PHMASK 0xFFFF
#endif
#define PH(k) if (PHMASK & (1 << (k)))
#ifndef DUPMASK
#define DUPMASK 0
#endif
#define REP(k) for (int rep_ = 0, nrep_ = opaque_int(((DUPMASK >> (k)) & 1) + 1); rep_ < nrep_; ++rep_)
__global__ void __launch_bounds__(512, 2) fwd_kernel(Params p) {
    extern __shared__ __attribute__((aligned(16))) unsigned char lds_all[];
    const int tid = threadIdx.x;
    const int wave0 = __builtin_amdgcn_readfirstlane(tid >> 6);
    const int G0 = gridDim.x; const int bx0 = blockIdx.x;
    const int vcu0 = (G0 % 8 == 0) ? (bx0 % 8) * (G0 / 8) + bx0 / 8 : bx0;
    LAS unsigned char* ldsc = (LAS unsigned char*)lds_all;
    volatile LAS unsigned* LP = (volatile LAS unsigned*)(ldsc + LC_PTR);
#define INP(k) ((const float*)ldp(LP, (k)))
#define WSP() ((unsigned char*)ldp(LP, I_WS))
#define OUTP() ((float*)ldp(LP, I_OUT))
    for (int u = tid; u < LDSCTL_BYTES / 4; u += 512) ((LAS unsigned*)ldsc)[u] = 0u;
    __syncthreads();
    if (tid == 0) {
        volatile LAS unsigned long long* T = (volatile LAS unsigned long long*)(ldsc + LC_PTR);
        T[I_X] = (unsigned long long)p.x; T[I_C] = (unsigned long long)p.c; T[I_CTX] = (unsigned long long)p.ctx; T[I_CCTX] = (unsigned long long)p.c_ctx;
        T[I_WIN] = (unsigned long long)p.w_in; T[I_WOUT] = (unsigned long long)p.w_out; T[I_ADAW] = (unsigned long long)p.ada_w; T[I_ADAB] = (unsigned long long)p.ada_b;
        T[I_N1W] = (unsigned long long)p.norm1_w; T[I_N2W] = (unsigned long long)p.norm2_w; T[I_DLAM] = (unsigned long long)p.diff_lambda; T[I_DNW] = (unsigned long long)p.diff_norm_w;
        T[I_POOLW] = (unsigned long long)p.pool_w; T[I_POOLS] = (unsigned long long)p.pool_scale; T[I_RAF] = (unsigned long long)p.ret_a_f; T[I_RAB] = (unsigned long long)p.ret_a_b;
        T[I_RNW] = (unsigned long long)p.ret_norm_w; T[I_RW] = (unsigned long long)p.router_w; T[I_RB] = (unsigned long long)p.router_b; T[I_MG] = (unsigned long long)p.moe_g;
        T[I_MU] = (unsigned long long)p.moe_u; T[I_MD] = (unsigned long long)p.moe_d; T[I_FNW] = (unsigned long long)p.final_norm_w; T[I_OUT] = (unsigned long long)p.out; T[I_WS] = (unsigned long long)p.ws;
    }
    __syncthreads();
    XcdBarrier bar = xcd_barrier_post((unsigned*)(WSP() + WS_CTL) + CW_BAR, (volatile LAS unsigned*)(ldsc + LC_BARW));
#define GRID_BAR() xcd_barrier(bar)
#define WSPTRS() const int tid = opaque_tid(wave0), lane = tid & 63, wave = __builtin_amdgcn_readfirstlane(tid >> 6); const int G = opaque_int(G0), bx = opaque_int(bx0), vcu = opaque_int(vcu0), NGW = G * 8; const int gw = vcu * 8 + wave; \
    unsigned char* const lds = lds_all + opaque_int(RING_OFF); LAS unsigned char* ldsl = (LAS unsigned char*)lds; (void)lane; (void)gw; (void)bx; (void)NGW; (void)ldsl; unsigned char* ws = WSP(); unsigned* ctl = (unsigned*)(ws + WS_CTL); float* MODV = (float*)(ws + WS_MOD); float* ROPEC = (float*)(ws + WS_ROPE); float* ROPES = ROPEC + 1024; \
    bf16_t* POOLWT = (bf16_t*)(ws + WS_POOLW); float* GATE = (float*)(ws + WS_GATE); int* TOK = (int*)(ws + WS_TOK); float* XC = (float*)(ws + WS_XC); float* KV = (float*)(ws + WS_KV); \
    bf16_t* ST = (bf16_t*)(ws + WS_ST); bf16_t* WIN = (bf16_t*)(ws + WS_WIN); bf16_t* WOUT = (bf16_t*)(ws + WS_WOUT); unsigned char* WGU = ws + WS_WGU; unsigned char* WDN = ws + WS_WDN; unsigned char* H8 = ws + WS_H8; unsigned char* QK8 = ws + WS_QK8; unsigned char* VT8 = ws + WS_VT8; (void)QK8; (void)VT8; \
    bf16_t* H = (bf16_t*)(ws + WS_H); bf16_t* XB = (bf16_t*)(ws + WS_XB); (void)XB; bf16_t* P = (bf16_t*)(ws + WS_P); bf16_t* MIX = (bf16_t*)(ws + WS_MIX); unsigned char* ACT = ws + WS_ACT; unsigned char* Y2 = ws + WS_Y2; float* OUT = OUTP(); \
    (void)ctl; (void)MODV; (void)ROPEC; (void)ROPES; (void)POOLWT; (void)GATE; (void)TOK; (void)XC; (void)KV; (void)ST; (void)WIN; (void)WOUT; (void)WGU; (void)WDN; (void)H8; (void)H; (void)P; (void)MIX; (void)ACT; (void)Y2; (void)OUT

    PH(0) REP(0) { WSPTRS();
        float* scr = (float*)(lds + wave * 8448);
        for (int mb = vcu; mb < 192 + 17; mb += G) {
        if (mb < 192) {
            float* sil = (float*)(lds + 72 * 1024);
            float* part = (float*)(lds + 108 * 1024);
            for (int i = tid; i < 9 * 1024; i += 512) { const int r = i >> 10, k = i & 1023; const float cv = (r < 8) ? INP(I_C)[r * 1024 + k] : INP(I_CCTX)[k]; sil[i] = cv / (1.0f + expf(-cv)); }
            __syncthreads();
            const int l = mb / 48, n0 = (mb - l * 48) * 128, cl = (wave & 1) * 64 + lane, kq = wave >> 1;
            const float* wp = INP(I_ADAW) + (size_t)l * 1024 * 6144 + (size_t)(kq * 256) * 6144 + n0 + cl;
            float a[9];
#pragma unroll
            for (int r = 0; r < 9; ++r) a[r] = 0.f;
            for (int k = 0; k < 256; k += 16) {
                float wv[16];
#pragma unroll
                for (int q = 0; q < 16; ++q) wv[q] = wp[(size_t)(k + q) * 6144];
#pragma unroll
                for (int q4 = 0; q4 < 4; ++q4)
#pragma unroll
                    for (int r = 0; r < 9; ++r) { const f32x4 s4 = *(const f32x4*)(sil + r * 1024 + kq * 256 + k + 4 * q4);
                        a[r] += (s4[0] * wv[4 * q4] + s4[1] * wv[4 * q4 + 1]) + (s4[2] * wv[4 * q4 + 2] + s4[3] * wv[4 * q4 + 3]); }
            }
#pragma unroll
            for (int r = 0; r < 9; ++r) part[(kq * 9 + r) * 128 + cl] = a[r];
            __syncthreads();
            for (int i = tid; i < 9 * 128; i += 512) { const int r = i >> 7, c = i & 127;
                MODV[((size_t)l * 9 + r) * 6144 + n0 + c] = INP(I_ADAB)[l * 6144 + n0 + c] + ((part[(0 * 9 + r) * 128 + c] + part[(1 * 9 + r) * 128 + c]) + (part[(2 * 9 + r) * 128 + c] + part[(3 * 9 + r) * 128 + c])); }
            __syncthreads();
        }
        if (mb == 192) {
            for (int i = tid; i < 1024; i += 512) { const int pos = i >> 4, f = i & 15; const double inv = pow(10000.0, -(double)f / 16.0); const double ang = (double)pos * inv; ROPEC[i] = (float)cos(ang); ROPES[i] = (float)sin(ang); }
        }
        if (mb >= 193) {
            const int lg = mb - 193;
            for (int i = tid; i < 4096; i += 512) { const int j = i >> 6, c = i & 63; POOLWT[(size_t)lg * 4096 + i] = f2bf(INP(I_POOLW)[(size_t)lg * 4096 + c * 64 + j]); }
        }
        }
        constexpr int I_IN = 16 * 44, I_OUT = 16 * 16, I_L = I_IN + I_OUT, I_E = 192, I_DENSE = 4 * I_L, NITEMS = I_DENSE + 64 * 3 * I_E;
        for (int it = gw; it < NITEMS; it += NGW) {
            const float* W_; unsigned char* dst_; int N_, K_, kind_, fp8_, item_;
            if (it < I_DENSE) { const int l_ = it / I_L, r_ = it - l_ * I_L;
                if (r_ < I_IN) { W_ = INP(I_WIN) + (size_t)l_ * 1024 * INW; K_ = 1024; N_ = INW; dst_ = (unsigned char*)WIN + (size_t)l_ * INW * 1024; kind_ = 0; fp8_ = 1; item_ = r_; }
                else { W_ = INP(I_WOUT) + (size_t)l_ * 1024 * 1024; K_ = 1024; N_ = 1024; dst_ = (unsigned char*)(WOUT + (size_t)l_ * 1024 * 1024); kind_ = 1; fp8_ = 0; item_ = r_ - I_IN; }
            } else { const int j_ = it - I_DENSE, le_ = j_ / (3 * I_E), r_ = j_ - le_ * 3 * I_E, which_ = r_ / I_E; item_ = r_ - which_ * I_E; fp8_ = 1;
                if (which_ == 0) { W_ = INP(I_MG) + (size_t)le_ * 1024 * DE; K_ = 1024; N_ = DE; dst_ = WGU + (size_t)le_ * NGU * 1024; kind_ = 2; }
                else if (which_ == 1) { W_ = INP(I_MU) + (size_t)le_ * 1024 * DE; K_ = 1024; N_ = DE; dst_ = WGU + (size_t)le_ * NGU * 1024; kind_ = 3; }
                else { W_ = INP(I_MD) + (size_t)le_ * DE * 1024; K_ = DE; N_ = 1024; dst_ = WDN + (size_t)le_ * 1024 * DE; kind_ = 1; } }
            const int nblk_ = N_ / 64, kb_ = item_ / nblk_, nb_ = item_ - kb_ * nblk_, k0_ = 64 * kb_, n_ = 64 * nb_ + lane;
            float tv[64];
            { const float* p_ = W_ + (size_t)k0_ * N_ + n_; const size_t st_ = (size_t)N_;
#pragma unroll
              for (int i = 0; i < 64; ++i) { tv[i] = *p_; p_ += st_; asm volatile("" : "+v"(p_)); } }
            const size_t drow = (size_t)rowmap(kind_, n_) * K_ + k0_;
            if (fp8_) {
#pragma unroll
                for (int j = 0; j < 4; ++j) { u32x4 o;
#pragma unroll
                    for (int q = 0; q < 4; ++q) o[q] = pk4_fp8(tv[16 * j + 4 * q] * pg8::WSCALE, tv[16 * j + 4 * q + 1] * pg8::WSCALE, tv[16 * j + 4 * q + 2] * pg8::WSCALE, tv[16 * j + 4 * q + 3] * pg8::WSCALE);
                    *(u32x4*)(dst_ + drow + 16 * j) = o; }
            } else {
#pragma unroll
                for (int j = 0; j < 8; ++j) { u32x4 o;
#pragma unroll
                    for (int q = 0; q < 4; ++q) o[q] = cvt_pk_bf16(tv[8 * j + 2 * q], tv[8 * j + 2 * q + 1]);
                    *(u32x4*)((bf16_t*)dst_ + drow + 8 * j) = o; }
            }
        }
    }
    GRID_BAR();

    for (int l = 0; l < DEPTH; ++l) {
        const bool last = (l == DEPTH - 1);
        const float lam_init = 0.8f - 0.6f * expf(-0.3f * (float)l);
        PH(1) REP(1) { WSPTRS(); const float* modl = MODV + (size_t)l * 9 * 6144;
            const float* nw = INP(I_N1W) + l * D;
            const float* xin = INP(I_X); const float* cin = INP(I_CTX);
            const int CH = (M + NGW - 1) / NGW;
            const int r0 = gw * CH, r1 = (r0 + CH < M) ? r0 + CH : M;
            int curvar = -1;
            f32x4 wsc[4] = {}, shv[4] = {}, g2v[4] = {};
            f32x4 xv[4] = {}; unsigned ya[4] = {}, yb[4] = {};
#define N1_SRC(row_, ptr_) do { const int b_ = (row_) / LT, j_ = (row_) - b_ * LT; const bool c_ = j_ < LC; const size_t xo_ = c_ ? ((size_t)(b_ * LC + j_)) * D : ((size_t)(b_ * L + j_ - LC)) * D; \
        ptr_ = (c_ ? cin : xin) + xo_; } while (0)
#define N1_LOAD(row_, X_, A_, B_) do { if (l == 0) { const float* sp_; N1_SRC(row_, sp_); _Pragma("unroll") for (int jj = 0; jj < 4; ++jj) X_[jj] = *(const f32x4*)(sp_ + 4 * lane + 256 * jj); } \
        else { _Pragma("unroll") for (int jj = 0; jj < 4; ++jj) X_[jj] = bf4_to_f4(*(const u32x2*)(XB + (size_t)(row_) * D + 4 * lane + 256 * jj)); } \
        if (l > 0) { const unsigned char* y0_ = Y2 + (size_t)(2 * (row_)) * D; _Pragma("unroll") for (int jj = 0; jj < 4; ++jj) { A_[jj] = *(const unsigned*)(y0_ + 4 * lane + 256 * jj); B_[jj] = *(const unsigned*)(y0_ + D + 4 * lane + 256 * jj); } } } while (0)
            if (r0 < r1) N1_LOAD(r0, xv, ya, yb);
            for (int row = r0; row < r1; ++row) {
                f32x4 xn[4] = {}; unsigned yan[4] = {}, ybn[4] = {};
                if (row + 1 < r1) N1_LOAD(row + 1, xn, yan, ybn);
                const int b = row / LT, j = row - b * LT; const bool isctx = j < LC; const int var = isctx ? 8 : b;
                if (var != curvar) {
                    curvar = var;
                    const float* mod = modl + (size_t)var * 6144;
                    const float* g2 = MODV + ((size_t)(l > 0 ? l - 1 : 0) * 9 + var) * 6144 + 5 * 1024;
#pragma unroll
                    for (int jj = 0; jj < 4; ++jj) { const int cc = 4 * lane + 256 * jj; wsc[jj] = *(const f32x4*)(nw + cc) * (*(const f32x4*)(mod + 1024 + cc) + 1.0f); shv[jj] = *(const f32x4*)(mod + cc); g2v[jj] = *(const f32x4*)(g2 + cc) * pg8::YINV; }
                }
                if (l > 0) {
#pragma unroll
                    for (int jj = 0; jj < 4; ++jj) { xv[jj] = xv[jj] + g2v[jj] * (fp8x4_to_f4(ya[jj]) + fp8x4_to_f4(yb[jj]));
                        u32x2 w; w.x = cvt_pk_bf16(xv[jj][0], xv[jj][1]); w.y = cvt_pk_bf16(xv[jj][2], xv[jj][3]); *(u32x2*)(XB + (size_t)row * D + 4 * lane + 256 * jj) = w; xv[jj] = bf4_to_f4(w); }
                }
                float ss = 0.f;
#pragma unroll
                for (int jj = 0; jj < 4; ++jj) ss += (xv[jj][0] * xv[jj][0] + xv[jj][1] * xv[jj][1]) + (xv[jj][2] * xv[jj][2] + xv[jj][3] * xv[jj][3]);
                ss = wave_sum(ss, lane);
                const float rstd = __builtin_amdgcn_rsqf(ss * (1.0f / D) + EPS);
#pragma unroll
                for (int jj = 0; jj < 4; ++jj) {
                    const f32x4 hv = xv[jj] * rstd * wsc[jj] + shv[jj];
                    *(unsigned*)((unsigned char*)H + (size_t)row * D + 4 * lane + 256 * jj) = pk4_fp8(hv[0], hv[1], hv[2], hv[3]);
                }
#pragma unroll
                for (int jj = 0; jj < 4; ++jj) { xv[jj] = xn[jj]; ya[jj] = yan[jj]; yb[jj] = ybn[jj]; }
            }
#undef N1_SRC
#undef N1_LOAD
        }
        GRID_BAR();
        PH(2) REP(2) { WSPTRS();
            pg8::DenseSched S; S.init(M, INW, D, G, bx, (unsigned char*)WIN + (size_t)l * INW * 1024, false, 1);
            pg8::EpiG1 E{P, ROPEC, ROPES, QK8};
            pg8::gemm_phase<pg8::EpiG1, pg8::DenseSched, true>(ldsl, (const char*)H, D, S, E, wave0);
        }
        GRID_BAR();
        PH(3) REP(3) { WSPTRS();
            {
                using namespace att;
                char* Vi = (char*)lds; char* Kf = (char*)lds + 16384; char* Kb = (char*)lds + 32768;
                const int dir = wave >> 2, eb = (wave >> 1) & 1, db = wave & 1, r32 = lane & 31, hi = lane >> 5;
                for (int it = vcu; it < NB * NCH * 4; it += G) {
                    const int h = it & 3, bc = it >> 2, b = bc / NCH, ch = bc - b * NCH;
                    const int rowbase = b * LT + ch * 128;
                    const float lgf2 = -expf(INP(I_RAF)[l * 4 + h]) * LOG2E, lgb2 = -expf(INP(I_RAB)[l * 4 + h]) * LOG2E;
#pragma unroll
                    for (int i = 0; i < 2; ++i) { const int chunk = tid + 512 * i, c = chunk >> 3, c8 = (chunk & 7) * 8;
                        const int off = (c >> 6) * 8192 + v_st<2>(c & 63, c8);
                        *(bf16x8*)(Vi + off) = *(const bf16x8*)(P + (size_t)(rowbase + c) * INW + OFF_RV + h * 64 + c8);
                        const bf16x8 kk = *(const bf16x8*)(P + (size_t)(rowbase + c) * INW + OFF_RK + h * 64 + c8);
                        const float zf = __builtin_amdgcn_exp2f(lgf2 * (float)(127 - c)), zb = __builtin_amdgcn_exp2f(lgb2 * (float)c);
                        u32x4 wf, wb;
#pragma unroll
                        for (int z = 0; z < 4; ++z) { const float a0 = bf2f((bf16_t)kk[2 * z]), a1 = bf2f((bf16_t)kk[2 * z + 1]); wf[z] = cvt_pk_bf16(a0 * zf, a1 * zf); wb[z] = cvt_pk_bf16(a0 * zb, a1 * zb); }
                        *(u32x4*)(Kf + off) = wf; *(u32x4*)(Kb + off) = wb; }
                    __syncthreads();
                    f32x16 acc = {};
                    const int vbase = (int)(uintptr_t)Vi + v_rd_base(lane) + eb * 512;
                    const int kbase = (int)(uintptr_t)(dir ? Kb : Kf) + v_rd_base(lane) + db * 512;
#pragma unroll
                    for (int tt = 0; tt < 2; ++tt)
#pragma unroll
                        for (int ks = 0; ks < 4; ++ks) {
                            s16x4 al, ah, bl, bh;
                            asm volatile("ds_read_b64_tr_b16 %0, %1 offset:%2" : "=&v"(al) : "v"(vbase), "i"(tt * 8192 + ks * 2048) : "memory");
                            asm volatile("ds_read_b64_tr_b16 %0, %1 offset:%2" : "=&v"(ah) : "v"(vbase), "i"(tt * 8192 + ks * 2048 + 1024) : "memory");
                            asm volatile("ds_read_b64_tr_b16 %0, %1 offset:%2" : "=&v"(bl) : "v"(kbase), "i"(tt * 8192 + ks * 2048) : "memory");
                            asm volatile("ds_read_b64_tr_b16 %0, %1 offset:%2" : "=&v"(bh) : "v"(kbase), "i"(tt * 8192 + ks * 2048 + 1024) : "memory");
                            asm volatile("s_waitcnt lgkmcnt(0)" ::: "memory"); SBAR();
                            const bf16x8 av = (bf16x8){al[0], al[1], al[2], al[3], ah[0], ah[1], ah[2], ah[3]}, bv = (bf16x8){bl[0], bl[1], bl[2], bl[3], bh[0], bh[1], bh[2], bh[3]};
                            acc = __builtin_amdgcn_mfma_f32_32x32x16_bf16(av, bv, acc, 0, 0, 0);
                        }
                    float* op = KV + ((size_t)(((b * 4 + h) * 2 + dir) * NCH + ch)) * 4096 + (size_t)(eb * 32) * 64 + db * 32 + r32;
#pragma unroll
                    for (int r = 0; r < 16; ++r) op[crow(r, hi) * 64] = acc[r];
                    __syncthreads();
                }
            }
            {
                bf16_t* Vt = (bf16_t*)lds;
                for (int it = vcu; it < NB * 4 * (LT / 64); it += G) {
                    const int t = it % (LT / 64), bh = it / (LT / 64), b = bh >> 2, h = bh & 3;
                    const size_t row0 = (size_t)b * LT + (size_t)t * 64;
#pragma unroll
                    for (int i = 0; i < 2; ++i) { const int chunk = tid + 512 * i, key = chunk >> 4, c8 = (chunk & 15) * 8;
                        *(bf16x8*)(Vt + key * 136 + c8) = *(const bf16x8*)(P + (row0 + key) * INW + OFF_DV + h * 128 + c8); }
                    __syncthreads();
                    { const int e = tid >> 2, q = tid & 3, hi2 = q >> 1, sb = 16 * (q & 1);
                      float v[16];
#pragma unroll
                      for (int jx = 0; jx < 16; ++jx) { const int sx = sb + jx; const int key = (sx < 16) ? ((sx & 3) + 8 * (sx >> 2) + 4 * hi2) : (32 + ((sx - 16) & 3) + 8 * ((sx - 16) >> 2) + 4 * hi2); v[jx] = bf2f(Vt[key * 136 + e]); }
                      u32x4 w; w.x = pk4_fp8(v[0], v[1], v[2], v[3]); w.y = pk4_fp8(v[4], v[5], v[6], v[7]); w.z = pk4_fp8(v[8], v[9], v[10], v[11]); w.w = pk4_fp8(v[12], v[13], v[14], v[15]);
                      *(u32x4*)(VT8 + (size_t)it * 8192 + e * 64 + q * 16) = w; }
                    __syncthreads();
                }
            }
        }
        GRID_BAR();
        PH(4) REP(4) { WSPTRS();
            const int nskip = (!last && G > 128) ? 64 : 0;
            if (vcu >= nskip) for (int idx = (vcu - nskip) * 512 + tid; idx < 64 * 4096; idx += (G - nskip) * 512) {
                const int scan = idx >> 12, el = idx & 4095, dir = scan & 1, h = (scan >> 1) & 3;
                const float lg2 = -expf(dir ? INP(I_RAB)[l * 4 + h] : INP(I_RAF)[l * 4 + h]) * LOG2E;
                const float g = __builtin_amdgcn_exp2f(lg2 * 128.0f);
                const float* base = KV + (size_t)scan * NCH * 4096 + el;
                bf16_t* sb = ST + (size_t)scan * NCH * 4096 + el;
                float v[NCH];
#pragma unroll
                for (int ch = 0; ch < NCH; ++ch) v[ch] = base[(size_t)ch * 4096];
                float st = 0.f;
                if (dir == 0) {
#pragma unroll
                    for (int ch = 0; ch < NCH; ++ch) { sb[(size_t)ch * 4096] = f2bf(st); st = g * st + v[ch]; }
                } else {
                    sb[(size_t)1 * 4096] = f2bf(st); st = g * st + v[1];
                    sb[(size_t)0 * 4096] = f2bf(st); st = g * st + v[0];
#pragma unroll
                    for (int ch = NCH - 1; ch >= 2; --ch) { sb[(size_t)ch * 4096] = f2bf(st); st = g * st + v[ch]; }
                }
            }
            const float* dl = INP(I_DLAM) + l * 256;
            const float s1 = wave_sum(dl[lane] * dl[64 + lane], lane), s2 = wave_sum(dl[128 + lane] * dl[192 + lane], lane);
            const float lam = expf(s1) - expf(s2) + lam_init;
            const float* nw = INP(I_DNW) + l * 128;
            const float oscale = 1.0f - lam_init;
            const int nlat = NB * 4 * 32, nunits = nlat + (last ? 0 : 64);
            for (int Lx = vcu; Lx < nunits; Lx += G) {
                int qrow0, krow0, seq, h, bh;
                if (Lx < nlat) { bh = Lx >> 5; const int qb = Lx & 31, b = bh >> 2; h = bh & 3; qrow0 = b * LT + LC + qb * 128; krow0 = b * LT; seq = LT; }
                else { const int c_ = Lx - nlat; bh = c_ >> 1; const int qb = c_ & 1, b = bh >> 2; h = bh & 3; qrow0 = b * LT + qb * 128; krow0 = b * LT; seq = LC; }
                att::attn_unit8(QK8, VT8, qrow0, krow0, seq, bh, h, lam, nw, oscale, MIX, (char*)lds, wave0);
            }
        }
        GRID_BAR();
        PH(5) REP(5) { WSPTRS();
            using namespace att;
            const bool g2c = !last && G == 256;
            const int GW = g2c ? G - 32 : G, nctx = last ? 0 : 32;
            unsigned* ctxcnt = ctl + CW_CTX + 64 * l;
            if (g2c && vcu >= GW) {
                if (rep_ == 0) {
                if (tid == 0) { unsigned sp_ = 0; while (xb_ld(ctxcnt) < 64u) { __builtin_amdgcn_s_sleep(2); if (++sp_ > (1u << 22)) break; }
                    __builtin_amdgcn_fence(__ATOMIC_ACQUIRE, "agent"); asm volatile("s_waitcnt vmcnt(0)" ::: "memory"); }
                __syncthreads();
                const int k = vcu - GW; const float* modl = MODV + (size_t)l * 9 * 6144;
                pg8::OneSched S{(k >> 2) * 17, k & 3, (const char*)(WOUT + (size_t)l * 1024 * 1024), 2 * D};
                pg8::EpiG2 E{INP(I_X), INP(I_CTX), XB, modl, l == 0};
                pg8::gemm_phase<pg8::EpiG2, pg8::OneSched>(ldsl, (const char*)MIX, D, S, E, wave0);
                }
            } else
            for (int pass = (nctx ? 0 : 1); pass < 2; ++pass) {
            const int nret = pass == 0 ? nctx : 512;
            for (int p = pass == 0 ? vcu : (vcu + GW - 64) % GW; p < nret; p += GW) {
                int b, ch, hp;
                if (pass == 0) { b = p >> 2; ch = (p >> 1) & 1; hp = p & 1; } else { b = p >> 6; ch = 2 + ((p >> 1) & 31); hp = p & 1; }
                const int wq = wave & 3, hh = wave >> 2, h = hp * 2 + hh, r32 = lane & 31, hi = lane >> 5;
                const int rowbase = b * LT + ch * 128;
                const float lgf2 = -expf(INP(I_RAF)[l * 4 + h]) * LOG2E, lgb2 = -expf(INP(I_RAB)[l * 4 + h]) * LOG2E;
                char* Hl = (char*)lds + hh * 49152; char* Vl = Hl; char* Kl = Hl + 16384; char* Fl = Hl + 32768; char* Bl = Hl + 40960;
                {
                    const int t4 = tid & 255;
                    const bf16_t* Ft = ST + ((size_t)(((b * 4 + h) * 2 + 0) * NCH + ch)) * 4096;
                    const bf16_t* Bt = ST + ((size_t)(((b * 4 + h) * 2 + 1) * NCH + ch)) * 4096;
                    bf16x8 lv[4], lk[4], lf[2], lb[2];
#pragma unroll
                    for (int i = 0; i < 4; ++i) { const int chunk = t4 + 256 * i, k = chunk >> 3, c8 = (chunk & 7) * 8;
                        lv[i] = *(const bf16x8*)(P + (size_t)(rowbase + k) * INW + OFF_RV + h * 64 + c8);
                        lk[i] = *(const bf16x8*)(P + (size_t)(rowbase + k) * INW + OFF_RK + h * 64 + c8); }
#pragma unroll
                    for (int i = 0; i < 2; ++i) { const int chunk = t4 + 256 * i; lf[i] = *(const bf16x8*)(Ft + chunk * 8); lb[i] = *(const bf16x8*)(Bt + chunk * 8); }
#pragma unroll
                    for (int i = 0; i < 4; ++i) { const int chunk = t4 + 256 * i, k = chunk >> 3, c = chunk & 7;
                        *(bf16x8*)(Vl + (k >> 6) * 8192 + v_st<2>(k & 63, c * 8)) = lv[i];
                        *(bf16x8*)(Kl + k * 128 + ((c ^ (k & 7)) << 4)) = lk[i]; }
#pragma unroll
                    for (int i = 0; i < 2; ++i) { const int chunk = t4 + 256 * i, e = chunk >> 3, c = chunk & 7;
                        *(bf16x8*)(Fl + e * 128 + ((c ^ (e & 7)) << 4)) = lf[i]; *(bf16x8*)(Bl + e * 128 + ((c ^ (e & 7)) << 4)) = lb[i]; }
                }
                const int cq = wq * 32 + r32;
                bf16x8 qr[4];
                const bf16_t* Qw = P + (size_t)(rowbase + cq) * INW + OFF_RQ + h * 64 + hi * 8;
#pragma unroll
                for (int d0 = 0; d0 < 4; ++d0) qr[d0] = ld8(Qw + d0 * 16);
                __syncthreads();
                f32x16 o[2] = {};
                const int vb = (int)(uintptr_t)Vl + v_rd_base(lane);
#pragma unroll 1
                for (int tt = 0; tt < 2; ++tt) {
                    f32x16 p0 = {}, p1 = {};
                    const char* Ka = Kl + (tt * 64 + r32) * 128; const char* Kb2 = Ka + 32 * 128;
#pragma unroll
                    for (int d0 = 0; d0 < 4; ++d0) {
                        const int c = ((2 * d0 + hi) ^ (r32 & 7)) << 4;
                        const bf16x8 k0 = *(const bf16x8*)(Ka + c), k1 = *(const bf16x8*)(Kb2 + c);
                        p0 = __builtin_amdgcn_mfma_f32_32x32x16_bf16(k0, qr[d0], p0, 0, 0, 0);
                        p1 = __builtin_amdgcn_mfma_f32_32x32x16_bf16(k1, qr[d0], p1, 0, 0, 0);
                    }
#pragma unroll
                    for (int r = 0; r < 16; ++r) {
                        const int s0 = tt * 64 + crow(r, hi);
                        const int d0_ = cq - s0, d1_ = cq - (s0 + 32);
                        const float w0 = d0_ >= 0 ? __builtin_amdgcn_exp2f(lgf2 * (float)d0_) : __builtin_amdgcn_exp2f(lgb2 * (float)(-d0_));
                        const float w1 = d1_ >= 0 ? __builtin_amdgcn_exp2f(lgf2 * (float)d1_) : __builtin_amdgcn_exp2f(lgb2 * (float)(-d1_));
                        p0[r] *= w0; p1[r] *= w1;
                    }
                    bf16x8 pa0, pa1, pa2, pa3;
                    PK4(p0, 0, pa0); PK4(p0, 8, pa1); PK4(p1, 0, pa2); PK4(p1, 8, pa3);
                    pv2(o, vb + tt * 8192, pa0, pa1, pa2, pa3);
                }
                {
                    const float xf = __builtin_amdgcn_exp2f(lgf2 * (float)(cq + 1)), xb = __builtin_amdgcn_exp2f(lgb2 * (float)(128 - cq));
#pragma unroll
                    for (int d0 = 0; d0 < 4; ++d0) {
                        u32x4 qf, qb;
#pragma unroll
                        for (int z = 0; z < 4; ++z) { const float a0 = bf2f((bf16_t)qr[d0][2 * z]), a1 = bf2f((bf16_t)qr[d0][2 * z + 1]); qf[z] = cvtpk(a0 * xf, a1 * xf); qb[z] = cvtpk(a0 * xb, a1 * xb); }
                        const bf16x8 qfv = *reinterpret_cast<bf16x8*>(&qf), qbv = *reinterpret_cast<bf16x8*>(&qb);
#pragma unroll
                        for (int eb = 0; eb < 2; ++eb) {
                            const int e = eb * 32 + r32; const int c = ((2 * d0 + hi) ^ (e & 7)) << 4;
                            const bf16x8 f0 = *(const bf16x8*)(Fl + e * 128 + c), b0 = *(const bf16x8*)(Bl + e * 128 + c);
                            o[eb] = __builtin_amdgcn_mfma_f32_32x32x16_bf16(qfv, f0, o[eb], 0, 0, 0);
                            o[eb] = __builtin_amdgcn_mfma_f32_32x32x16_bf16(qbv, b0, o[eb], 0, 0, 0);
                        }
                    }
                }
                {
                    const float w0 = INP(I_RNW)[l * 256 + h * 64 + r32], w1 = INP(I_RNW)[l * 256 + h * 64 + 32 + r32];
                    bf16_t g0[16], g1[16];
#pragma unroll
                    for (int r = 0; r < 16; ++r) { const size_t row = (size_t)(rowbase + wq * 32 + crow(r, hi)); g0[r] = P[row * INW + OFF_RG + h * 64 + r32]; g1[r] = P[row * INW + OFF_RG + h * 64 + 32 + r32]; }
                    float ssv[16];
#pragma unroll
                    for (int r = 0; r < 16; ++r) ssv[r] = o[0][r] * o[0][r] + o[1][r] * o[1][r];
#pragma unroll
                    for (int st = 1; st < 32; st <<= 1)
#pragma unroll
                        for (int r = 0; r < 16; ++r) ssv[r] += shfl_xor_l(ssv[r], lane, st);
#pragma unroll
                    for (int r = 0; r < 16; ++r) {
                        const float rs = __builtin_amdgcn_rsqf(ssv[r] * (1.0f / 64.0f) + EPS);
                        const size_t row = (size_t)(rowbase + wq * 32 + crow(r, hi));
                        MIX[row * D + 768 + h * 64 + r32] = f2bf(silu_f(bf2f(g0[r])) * (o[0][r] * rs * w0));
                        MIX[row * D + 768 + h * 64 + 32 + r32] = f2bf(silu_f(bf2f(g1[r])) * (o[1][r] * rs * w1));
                    }
                }
                if (g2c && pass == 0 && rep_ == 0) { asm volatile("s_waitcnt vmcnt(0)" ::: "memory"); __syncthreads();
                    if (tid == 0) { __builtin_amdgcn_fence(__ATOMIC_RELEASE, "agent"); asm volatile("s_waitcnt vmcnt(0)" ::: "memory"); (void)xb_add(ctxcnt, 1u); } }
                __syncthreads();
            }
            __syncthreads();
            bf16_t* U = (bf16_t*)lds;
            bf16_t* DF = (bf16_t*)(lds + 45056);
            constexpr int US = 264;
            const int npool = pass == 0 ? nctx : 512;
            const bf16_t* pwt = POOLWT + (size_t)l * 4 * 4096;
            const int pg = wave >> 1, pth = wave & 1, pfr = lane & 15, pfq = lane >> 4;
            bf16x8 bfv[2][4]; f32x4 psv[4];
#pragma unroll
            for (int ks = 0; ks < 2; ++ks)
#pragma unroll
                for (int n = 0; n < 4; ++n) bfv[ks][n] = *(const bf16x8*)(pwt + (size_t)pg * 4096 + (16 * n + pfr) * 64 + 32 * ks + 8 * pfq);
#pragma unroll
            for (int n = 0; n < 4; ++n) psv[n] = *(const f32x4*)(INP(I_POOLS) + l * 256 + pg * 64 + 16 * n + 4 * pfq);
            bf16x8 uv[5] = {};
#define POOL_DEC(it_, b_, s0_, t0_, Ls_) do { if (pass == 1) { b_ = (it_) >> 6; t0_ = ((it_) & 63) * 64; s0_ = b_ * LT + LC; Ls_ = L; } else { b_ = (it_) >> 2; t0_ = ((it_) & 3) * 64; s0_ = b_ * LT; Ls_ = LC; } } while (0)
#define POOL_LOAD(it_) do { int b_, s0_, t0_, Ls_; POOL_DEC(it_, b_, s0_, t0_, Ls_); (void)b_; _Pragma("unroll") for (int i = 0; i < 5; ++i) { const int t = t0_ - 8 + (tid >> 5) + 16 * i; \
                bf16x8 v = {0, 0, 0, 0, 0, 0, 0, 0}; if (t >= 0 && t < Ls_) v = *(const bf16x8*)(P + (size_t)(s0_ + t) * INW + OFF_PU + (tid & 31) * 8); uv[i] = v; } } while (0)
            int it = pass == 0 ? (vcu + GW - 32) % GW : (vcu + GW - 128) % GW;
            if (it < npool) POOL_LOAD(it);
            for (; it < npool; it += GW) {
                int b, s0, t0, Ls; POOL_DEC(it, b, s0, t0, Ls); (void)b;
#pragma unroll
                for (int i = 0; i < 5; ++i) *(bf16x8*)(U + ((tid >> 5) + 16 * i) * US + (tid & 31) * 8) = uv[i];
                __syncthreads();
                if (it + GW < npool) POOL_LOAD(it + GW);
#pragma unroll 1
                for (int g = 0; g < 4; ++g) { const int tt = tid >> 3, c8 = g * 64 + (tid & 7) * 8, hw = 1 << g;
                    const int t = t0 + tt; int lo = t - hw; lo = lo < 0 ? 0 : lo; int hi2 = t + hw; hi2 = hi2 > Ls ? Ls : hi2;
                    float s[8] = {0.f, 0.f, 0.f, 0.f, 0.f, 0.f, 0.f, 0.f};
                    for (int q = lo; q < hi2; ++q) { const bf16x8 v = *(const bf16x8*)(U + (q - t0 + 8) * US + c8);
#pragma unroll
                        for (int z = 0; z < 8; ++z) s[z] += bf2f((bf16_t)v[z]); }
                    const float inv = 1.0f / (float)(hi2 - lo);
                    const bf16x8 me = *(const bf16x8*)(U + (tt + 8) * US + c8);
                    u32x4 o; float dv[8];
#pragma unroll
                    for (int z = 0; z < 8; ++z) dv[z] = s[z] * inv - bf2f((bf16_t)me[z]);
                    o.x = cvt_pk_bf16(dv[0], dv[1]); o.y = cvt_pk_bf16(dv[2], dv[3]); o.z = cvt_pk_bf16(dv[4], dv[5]); o.w = cvt_pk_bf16(dv[6], dv[7]);
                    *(u32x4*)(DF + tt * US + c8) = o; }
                __syncthreads();
                {
                    f32x4 acc[2][4];
#pragma unroll
                    for (int m = 0; m < 2; ++m)
#pragma unroll
                        for (int n = 0; n < 4; ++n) acc[m][n] = (f32x4){0.f, 0.f, 0.f, 0.f};
#pragma unroll
                    for (int ks = 0; ks < 2; ++ks) {
                        bf16x8 af[2];
#pragma unroll
                        for (int m = 0; m < 2; ++m) af[m] = *(const bf16x8*)(DF + (32 * pth + 16 * m + pfr) * US + pg * 64 + 32 * ks + 8 * pfq);
#pragma unroll
                        for (int m = 0; m < 2; ++m)
#pragma unroll
                            for (int n = 0; n < 4; ++n) acc[m][n] = __builtin_amdgcn_mfma_f32_16x16x32_bf16(bfv[ks][n], af[m], acc[m][n], 0, 0, 0);
                    }
#pragma unroll
                    for (int m = 0; m < 2; ++m)
#pragma unroll
                        for (int n = 0; n < 4; ++n) {
                            const int jc = pg * 64 + 16 * n + 4 * pfq;
                            const f32x4 r = acc[m][n] * psv[n];
                            u32x2 o; o.x = cvt_pk_bf16(r[0], r[1]); o.y = cvt_pk_bf16(r[2], r[3]);
                            *(u32x2*)(MIX + (size_t)(s0 + t0 + 32 * pth + 16 * m + pfr) * D + 512 + jc) = o;
                        }
                }
                if (g2c && pass == 0 && rep_ == 0) { asm volatile("s_waitcnt vmcnt(0)" ::: "memory"); __syncthreads();
                    if (tid == 0) { __builtin_amdgcn_fence(__ATOMIC_RELEASE, "agent"); asm volatile("s_waitcnt vmcnt(0)" ::: "memory"); (void)xb_add(ctxcnt, 1u); } }
                __syncthreads();
            }
#undef POOL_DEC
#undef POOL_LOAD
            __syncthreads();
            }
        }
        GRID_BAR();
        PH(6) REP(6) { WSPTRS(); const float* modl = MODV + (size_t)l * 9 * 6144;
            pg8::DenseSched S; S.init(M, D, D, G, bx, WOUT + (size_t)l * 1024 * 1024, last || G == 256);
            pg8::EpiG2 E{INP(I_X), INP(I_CTX), XB, modl, l == 0};
            pg8::gemm_phase<pg8::EpiG2, pg8::DenseSched>(ldsl, (const char*)MIX, D, S, E, wave0);
        }
        GRID_BAR();
        PH(7) REP(7) { WSPTRS(); const float* modl = MODV + (size_t)l * 9 * 6144;
            float* RWE = (float*)lds;
            float* PART = (float*)(lds_all + LC_PART);
            int* RI = (int*)(lds_all + LC_RI);
            float* RGt = (float*)(lds_all + LC_RG);
            volatile LAS int* lcnt = (volatile LAS int*)(ldsc + LC_LCNT);
            volatile LAS int* lbase = (volatile LAS int*)(ldsc + LC_BASE);
            const float* nw = INP(I_N2W) + l * D; const float* rwp = INP(I_RW); const float* rbp = INP(I_RB);
            for (int vb = vcu; vb < 256; vb += G) {
                const int b = vb >> 5, q = vb & 31; int row0, nrows; bool isctx = false;
                if (last) { row0 = b * LT + LC + q * 128; nrows = 128; }
                else if (q < 2) { isctx = true; row0 = b * LT + q * 128; nrows = 128; }
                else { row0 = b * LT + LC + (q - 2) * 137; nrows = L - (q - 2) * 137; nrows = nrows > 137 ? 137 : nrows; }
                const float* mod = modl + (size_t)(isctx ? 8 : b) * 6144;
                f32x4 wsc[4], shv[4];
#pragma unroll
                for (int jj = 0; jj < 4; ++jj) { const int cc = 4 * lane + 256 * jj; wsc[jj] = *(const f32x4*)(nw + cc) * (*(const f32x4*)(mod + 4096 + cc) + 1.0f); shv[jj] = *(const f32x4*)(mod + 3072 + cc); }
                if (tid < 16) lcnt[tid] = 0;
                float bp[16];
#pragma unroll
                for (int e = 0; e < 16; ++e) bp[e] = 0.f;
#pragma unroll
                for (int hh = 0; hh < 2; ++hh) {
                    const int k = tid + 512 * hh;
                    const float wk = nw[k] * (mod[4096 + k] + 1.0f), shk = mod[3072 + k];
                    float* dstp = RWE + (size_t)(((k >> 2) & 63) + 64 * ((k & 3) + 4 * (k >> 8))) * 20;
#pragma unroll
                    for (int e4 = 0; e4 < 4; ++e4) { const f32x4 r = *(const f32x4*)(rwp + k * 16 + 4 * e4); *(f32x4*)(dstp + 4 * e4) = r * wk;
                        bp[4 * e4 + 0] += shk * r[0]; bp[4 * e4 + 1] += shk * r[1]; bp[4 * e4 + 2] += shk * r[2]; bp[4 * e4 + 3] += shk * r[3]; }
                }
#pragma unroll
                for (int e = 0; e < 16; ++e) { const float t = wave_sum(bp[e], lane); if (lane == 0) PART[wave * 16 + e] = t; }
                __syncthreads();
                float rbv[16]; float lgb_lane = 0.f;
#pragma unroll
                for (int w = 0; w < 8; ++w) lgb_lane += PART[w * 16 + ((lane >> 2) & 15)];
#pragma unroll
                for (int e = 0; e < 16; ++e) rbv[e] = __int_as_float(__builtin_amdgcn_readfirstlane(__float_as_int(rbp[e])));
                float* LGS = (float*)(lds + 81920) + wave * (18 * 16);
                const bf16_t* xbase = XB + (size_t)row0 * D;
                f32x4 xv[4] = {};
                if (wave < nrows) {
#pragma unroll
                    for (int jj = 0; jj < 4; ++jj) xv[jj] = bf4_to_f4(*(const u32x2*)(xbase + (size_t)wave * D + 4 * lane + 256 * jj));
                }
                for (int rr = wave; rr < nrows; rr += 8) {
                    f32x4 xn[4] = {};
                    if (rr + 8 < nrows) {
#pragma unroll
                        for (int jj = 0; jj < 4; ++jj) xn[jj] = bf4_to_f4(*(const u32x2*)(xbase + (size_t)(rr + 8) * D + 4 * lane + 256 * jj));
                    }
                    float ss = 0.f; f32x2 d2[8];
#pragma unroll
                    for (int e = 0; e < 8; ++e) d2[e] = (f32x2){0.f, 0.f};
#pragma unroll
                    for (int jj = 0; jj < 4; ++jj) {
                        ss += (xv[jj][0] * xv[jj][0] + xv[jj][1] * xv[jj][1]) + (xv[jj][2] * xv[jj][2] + xv[jj][3] * xv[jj][3]);
                        f32x4 rr4[4][4];
#pragma unroll
                        for (int i = 0; i < 4; ++i) { const float* rw = RWE + (size_t)(lane + 64 * (i + 4 * jj)) * 20;
#pragma unroll
                            for (int q4 = 0; q4 < 4; ++q4) rr4[i][q4] = *(const f32x4*)(rw + 4 * q4); }
#pragma unroll
                        for (int i = 0; i < 4; ++i) { const f32x2 xk2 = (f32x2){xv[jj][i], xv[jj][i]};
#pragma unroll
                            for (int q4 = 0; q4 < 4; ++q4) { d2[2 * q4] = __builtin_elementwise_fma((f32x2){rr4[i][q4][0], rr4[i][q4][1]}, xk2, d2[2 * q4]); d2[2 * q4 + 1] = __builtin_elementwise_fma((f32x2){rr4[i][q4][2], rr4[i][q4][3]}, xk2, d2[2 * q4 + 1]); } }
                        __builtin_amdgcn_sched_barrier(0);
                    }
                    float dot[16];
#pragma unroll
                    for (int e = 0; e < 8; ++e) { dot[2 * e] = d2[e][0]; dot[2 * e + 1] = d2[e][1]; }
                    ss = wave_sum(ss, lane);
                    float t8[8], t4[4], t2[2], dv;
#pragma unroll
                    for (int i = 0; i < 8; ++i) { auto rr2 = __builtin_amdgcn_permlane32_swap(__float_as_uint(dot[i]), __float_as_uint(dot[i + 8]), false, false); t8[i] = __uint_as_float(rr2[0]) + __uint_as_float(rr2[1]); }
                    { const bool b4 = (lane & 16) != 0, b3 = (lane & 8) != 0, b2 = (lane & 4) != 0;
#pragma unroll
                      for (int i = 0; i < 4; ++i) { const float keep = b4 ? t8[i + 4] : t8[i], send = b4 ? t8[i] : t8[i + 4]; t4[i] = keep + shfl_xor_l(send, lane, 16); }
#pragma unroll
                      for (int i = 0; i < 2; ++i) { const float keep = b3 ? t4[i + 2] : t4[i], send = b3 ? t4[i] : t4[i + 2]; t2[i] = keep + shfl_xor_l(send, lane, 8); }
                      { const float keep = b2 ? t2[1] : t2[0], send = b2 ? t2[0] : t2[1]; dv = keep + shfl_xor_l(send, lane, 4); }
                      dv += shfl_xor_l(dv, lane, 2); dv += shfl_xor_l(dv, lane, 1); }
                    const float rstd = __builtin_amdgcn_rsqf(ss * (1.0f / D) + EPS);
                    const int row = row0 + rr;
#pragma unroll
                    for (int jj = 0; jj < 4; ++jj) {
                        const f32x4 hv = xv[jj] * rstd * wsc[jj] + shv[jj];
                        *(unsigned*)(H8 + (size_t)row * D + 4 * lane + 256 * jj) = pk4_fp8(hv[0], hv[1], hv[2], hv[3]);
                    }
                    if ((lane & 3) == 0) LGS[(rr >> 3) * 16 + (lane >> 2)] = dv * rstd + lgb_lane;
#pragma unroll
                    for (int jj = 0; jj < 4; ++jj) xv[jj] = xn[jj];
                }
                asm volatile("s_waitcnt lgkmcnt(0)" ::: "memory");
                {
                    const int rr = wave + 8 * lane;
                    if (rr < nrows) {
                        float sg[16], sel[16];
#pragma unroll
                        for (int e4 = 0; e4 < 4; ++e4) { const f32x4 lg4 = *(const f32x4*)(LGS + lane * 16 + 4 * e4);
#pragma unroll
                            for (int q4 = 0; q4 < 4; ++q4) { const int e = 4 * e4 + q4; sg[e] = __builtin_amdgcn_rcpf(1.0f + __builtin_amdgcn_exp2f(-lg4[q4] * LOG2E)); sel[e] = sg[e] + rbv[e]; } }
                        float best = -1e30f; int gi = 0;
#pragma unroll
                        for (int g = 0; g < 4; ++g) {
                            float m1 = -1e30f, m2 = -1e30f;
#pragma unroll
                            for (int qq = 0; qq < 4; ++qq) { const float x_ = sel[4 * g + qq]; if (x_ > m1) { m2 = m1; m1 = x_; } else if (x_ > m2) m2 = x_; }
                            const float gs = m1 + m2; if (gs > best) { best = gs; gi = g; }
                        }
                        float v1 = -1e30f, v2 = -1e30f; int i1 = 0, i2 = 0; float sa = 0.f, sb2 = 0.f;
#pragma unroll
                        for (int g = 0; g < 4; ++g)
#pragma unroll
                            for (int qq = 0; qq < 4; ++qq) if (g == gi) {
                                const float x_ = sel[4 * g + qq], sx = sg[4 * g + qq];
                                if (x_ > v1) { v2 = v1; i2 = i1; sb2 = sa; v1 = x_; i1 = 4 * g + qq; sa = sx; } else if (x_ > v2) { v2 = x_; i2 = 4 * g + qq; sb2 = sx; }
                            }
                        const float rden = 1.0f / (sa + sb2);
                        const int p0 = __hip_atomic_fetch_add((LAS int*)&lcnt[i1], 1, __ATOMIC_RELAXED, __HIP_MEMORY_SCOPE_WORKGROUP), p1 = __hip_atomic_fetch_add((LAS int*)&lcnt[i2], 1, __ATOMIC_RELAXED, __HIP_MEMORY_SCOPE_WORKGROUP);
                        RI[rr * 4 + 0] = i1; RI[rr * 4 + 1] = i2; RI[rr * 4 + 2] = p0; RI[rr * 4 + 3] = p1; RGt[rr * 2] = sa * rden; RGt[rr * 2 + 1] = sb2 * rden;
                    }
                }
                __syncthreads();
                if (tid < 16) { const int n = lcnt[tid]; lbase[tid] = n ? (int)__hip_atomic_fetch_add(ctl + CW_CNT + (l * 16 + tid) * 64, (unsigned)n, __ATOMIC_RELAXED, __HIP_MEMORY_SCOPE_AGENT) : 0; }
                __syncthreads();
                for (int qq = tid; qq < nrows * 2; qq += 512) {
                    const int rr = qq >> 1, k = qq & 1, row = row0 + rr;
                    const int e = RI[rr * 4 + k]; const int pos = lbase[e] + RI[rr * 4 + 2 + k]; const int pair = row * 2 + k; TOK[(size_t)e * CAP + pos] = pair; GATE[pair] = RGt[rr * 2 + k];
                }
                __syncthreads();
            }
        }
        GRID_BAR();
        PH(8) REP(8) { WSPTRS();
            volatile LAS int* tp = (volatile LAS int*)(ldsc + LC_TP);
            volatile LAS int* cn = (volatile LAS int*)(ldsc + LC_CNT);
            if (tid == 0) { int acc_ = 0; for (int e = 0; e < 16; ++e) { const int n = (int)__hip_atomic_load(ctl + CW_CNT + (l * 16 + e) * 64, __ATOMIC_RELAXED, __HIP_MEMORY_SCOPE_AGENT); cn[e] = n; tp[e] = acc_; acc_ += (n + 255) >> 8; } tp[16] = acc_; }
            __syncthreads();
            {
                pg8::MoeSched<true> S{G, bx, NGU / 256, D, (const char*)(WGU + (size_t)l * 16 * NGU * 1024), (size_t)NGU * 1024, (const LAS int*)tp, (const LAS int*)cn, TOK};
                pg8::EpiE1 E{ACT};
                pg8::gemm_phase<pg8::EpiE1, pg8::MoeSched<true>, true>(ldsl, (const char*)H8, D, S, E, wave0);
            }
            GRID_BAR();
            {
                pg8::MoeSched<false> S{G, bx, D / 256, DE, (const char*)(WDN + (size_t)l * 16 * 1024 * DE), (size_t)1024 * DE, (const LAS int*)tp, (const LAS int*)cn, TOK};
                pg8::EpiE2 E{Y2, TOK, GATE, (const LAS int*)cn};
                pg8::gemm_phase<pg8::EpiE2, pg8::MoeSched<false>, true>(ldsl, (const char*)ACT, DE, S, E, wave0);
            }
        }
        GRID_BAR();
    }
    PH(9) REP(9) { WSPTRS();
        const float* g2b = MODV + (size_t)3 * 9 * 6144 + 5 * 1024;
        for (int r = gw; r < NB * L; r += NGW) {
            const int b = r / L, t = r - b * L; const int row = b * LT + LC + t;
            float* xr = OUT + (size_t)r * D;
            const float* g2 = g2b + (size_t)b * 6144;
            const unsigned char* y0 = Y2 + (size_t)(2 * row) * D; const unsigned char* y1 = y0 + D;
            f32x4 v[4]; float ss = 0.f;
#pragma unroll
            for (int jj = 0; jj < 4; ++jj) {
                const int cc = 4 * lane + 256 * jj;
                const f32x4 a = fp8x4_to_f4(*(const unsigned*)(y0 + cc)), bb = fp8x4_to_f4(*(const unsigned*)(y1 + cc)), g = *(const f32x4*)(g2 + cc) * pg8::YINV;
                v[jj] = bf4_to_f4(*(const u32x2*)(XB + (size_t)row * D + cc)) + g * (a + bb);
                ss += (v[jj][0] * v[jj][0] + v[jj][1] * v[jj][1]) + (v[jj][2] * v[jj][2] + v[jj][3] * v[jj][3]);
            }
            ss = wave_sum(ss, lane);
            const float rstd = 1.0f / sqrtf(ss * (1.0f / D) + EPS);
#pragma unroll
            for (int jj = 0; jj < 4; ++jj) { const int cc = 4 * lane + 256 * jj; *(f32x4*)(xr + cc) = v[jj] * rstd * *(const f32x4*)(INP(I_FNW) + cc); }
        }
    }
}

extern "C" void kernel_launch(void* const* d_in, const int* in_sizes, int n_in, void* d_out, int out_size, void* d_ws, size_t ws_size, hipStream_t stream) {
    static int grid = 0;
    if (grid == 0) {
        if (n_in != 23 || out_size != NB * L * D || ws_size < WS_END) { fprintf(stderr, "kernel_launch: unexpected shapes (n_in %d out %d ws %zu, need ws >= %zu)\n", n_in, out_size, ws_size, (size_t)WS_END); grid = -1; return; }
        int dev = 0, cus = 0, per_cu = 0;
        if (hipGetDevice(&dev) != hipSuccess || hipDeviceGetAttribute(&cus, hipDeviceAttributeMultiprocessorCount, dev) != hipSuccess) { grid = -1; return; }
        if (hipFuncSetAttribute((const void*)fwd_kernel, hipFuncAttributeMaxDynamicSharedMemorySize, LDS_BYTES) != hipSuccess) { fprintf(stderr, "kernel_launch: hipFuncSetAttribute failed\n"); grid = -1; return; }
        if (hipOccupancyMaxActiveBlocksPerMultiprocessor(&per_cu, (const void*)fwd_kernel, 512, LDS_BYTES) != hipSuccess || per_cu < 1) fprintf(stderr, "kernel_launch: occupancy query reports %d\n", per_cu);
        (void)hipGetLastError();
        grid = cus;
    }
    if (grid < 0) return;
    (void)hipMemsetAsync((char*)d_ws + WS_CTL, 0, CTL_ZERO_BYTES, stream);
    Params p{};
    const float** pp = (const float**)&p;
    for (int i = 0; i < 23; ++i) pp[i] = (const float*)d_in[i];
    p.out = (float*)d_out; p.ws = (unsigned char*)d_ws;
    hipLaunchKernelGGL(fwd_kernel, dim3(grid), dim3(512), LDS_BYTES, stream, p);
    const hipError_t le = hipPeekAtLastError();
    if (le != hipSuccess) fprintf(stderr, "kernel_launch: launch failed: %s\n", hipGetErrorName(le));
}
```
